# Optimizing an MI355X kernel written in HIP

```python
import math
import jax, jax.numpy as jnp
from jax import lax
import numpy as np

D_MODEL = 1024
BATCH = 4
SEQ = 4096
DEPTH = 2

N_MIXERS = 2
N_MAMBA_LAYERS = (DEPTH + 1) // 2
N_ATTN_LAYERS = DEPTH // 2

SSM_EXPAND = 2
D_INNER = SSM_EXPAND * D_MODEL
SSM_HEAD_DIM = 64
SSM_HEADS = D_INNER // SSM_HEAD_DIM
SSM_GROUPS = 4
SSM_HEADS_PER_GROUP = SSM_HEADS // SSM_GROUPS
SSM_STATE = 128
CONV_WIDTH = 4
SSD_CHUNK = 128
CONV_DIM = D_INNER + 2 * SSM_GROUPS * SSM_STATE
IN_PROJ_DIM = 2 * D_INNER + 2 * SSM_GROUPS * SSM_STATE + SSM_HEADS

ATT_HEAD_DIM = 64
ATT_HEADS = D_MODEL // ATT_HEAD_DIM
DIL_PATTERNS = ((128, 1), (512, 4), (2048, 16))
N_DIL_GROUPS = len(DIL_PATTERNS)
QKV_DIM = N_DIL_GROUPS * 3 * ATT_HEADS * ATT_HEAD_DIM

FFN_HIDDEN = ((-(-8 * D_MODEL // 3) + 255) // 256) * 256

PLE_DIM = 256

NORM_EPS = 1e-6

kernel_name = "hybrid_ssd_dilated_attn_trunk"


def rmsnorm(x, gain):
    xf = x.astype(jnp.float32)
    y = xf * lax.rsqrt(jnp.mean(xf * xf, axis=-1, keepdims=True) + NORM_EPS)
    return (y * gain.astype(jnp.float32)).astype(x.dtype)


def causal_depthwise_conv(u, w, bias):
    k_width, chans = w.shape
    out = lax.conv_general_dilated(
        u, w[:, None, :].astype(u.dtype), window_strides=(1,),
        padding=[(k_width - 1, 0)], dimension_numbers=("NWC", "WIO", "NWC"),
        feature_group_count=chans)
    return out + bias.astype(u.dtype)


def ssd_chunked(x, dt, a, bm, cm):
    f32 = jnp.float32
    b, t = x.shape[:2]
    nc, cl = t // SSD_CHUNK, SSD_CHUNK
    g, hg = SSM_GROUPS, SSM_HEADS_PER_GROUP
    xs = (x.astype(f32) * dt[..., None]).reshape(b, nc, cl, g, hg, SSM_HEAD_DIM)
    a_dt = (dt * a).reshape(b, nc, cl, g, hg).transpose(0, 1, 3, 4, 2)
    a_cs = jnp.cumsum(a_dt, axis=-1)
    bc = bm.astype(f32).reshape(b, nc, cl, g, SSM_STATE)
    cc = cm.astype(f32).reshape(b, nc, cl, g, SSM_STATE)
    causal = jnp.tril(jnp.ones((cl, cl), dtype=bool))
    seg = a_cs[..., :, None] - a_cs[..., None, :]
    lmat = jnp.exp(jnp.where(causal, seg, -jnp.inf))
    cb = jnp.einsum("bclgn,bcsgn->bcgls", cc, bc)
    y_diag = jnp.einsum("bcgls,bcghls,bcsghp->bclghp", cb, lmat, xs)
    decay = jnp.exp(a_cs[..., -1:] - a_cs)
    states = jnp.einsum("bclgn,bcghl,bclghp->bcghpn", bc, decay, xs)
    chunk_decay = jnp.exp(a_cs[..., -1])

    def step(carry, inp):
        st, dec = inp
        return carry * dec[..., None, None] + st, carry

    init = jnp.zeros((b, g, hg, SSM_HEAD_DIM, SSM_STATE), f32)
    _, prev = lax.scan(step, init, (jnp.moveaxis(states, 1, 0), jnp.moveaxis(chunk_decay, 1, 0)))
    prev = jnp.moveaxis(prev, 0, 1)
    y_off = jnp.einsum("bclgn,bcghpn,bcghl->bclghp", cc, prev, jnp.exp(a_cs))
    return (y_diag + y_off).reshape(b, t, SSM_HEADS, SSM_HEAD_DIM)


def mamba2_mixer(h, w_in, conv_w, conv_b, dt_bias, a_log, d_skip, norm_w, w_out):
    b, t, _ = h.shape
    zxbcdt = h @ w_in.astype(h.dtype)
    z = zxbcdt[..., :D_INNER]
    xbc = zxbcdt[..., D_INNER:D_INNER + CONV_DIM]
    dt_raw = zxbcdt[..., D_INNER + CONV_DIM:]
    xbc = jax.nn.silu(causal_depthwise_conv(xbc, conv_w, conv_b))
    xs = xbc[..., :D_INNER]
    bm = xbc[..., D_INNER:D_INNER + SSM_GROUPS * SSM_STATE].reshape(b, t, SSM_GROUPS, SSM_STATE)
    cm = xbc[..., D_INNER + SSM_GROUPS * SSM_STATE:].reshape(b, t, SSM_GROUPS, SSM_STATE)
    dt = jax.nn.softplus(dt_raw.astype(jnp.float32) + dt_bias.astype(jnp.float32))
    a = -jnp.exp(a_log.astype(jnp.float32))
    xh = xs.reshape(b, t, SSM_HEADS, SSM_HEAD_DIM)
    y = ssd_chunked(xh, dt, a, bm, cm)
    y = y + xh.astype(jnp.float32) * d_skip.astype(jnp.float32)[:, None]
    y = y.reshape(b, t, D_INNER) * jax.nn.silu(z.astype(jnp.float32))
    y = rmsnorm(y.reshape(b, t, SSM_GROUPS, -1), norm_w.reshape(SSM_GROUPS, -1)).reshape(b, t, D_INNER)
    return y.astype(h.dtype) @ w_out.astype(h.dtype)


def alibi_slopes(n_heads):
    return 2.0 ** (-8.0 * jnp.arange(1, n_heads + 1, dtype=jnp.float32) / n_heads)


def dilated_group_attention(q, k, v, window, dilation, slopes):
    f32 = jnp.float32
    b, t, nh, e = q.shape
    span = window // dilation
    blk = span
    lu = t // dilation
    nb = -(-lu // blk)
    lp = nb * blk

    def to_blocks(arr):
        arr = arr.reshape(b, lu, dilation, nh, e)
        arr = jnp.pad(arr, ((0, 0), (0, lp - lu), (0, 0), (0, 0), (0, 0)))
        return arr.reshape(b, nb, blk, dilation, nh, e)

    qb, kb, vb = to_blocks(q.astype(f32)), to_blocks(k.astype(f32)), to_blocks(v.astype(f32))
    pad_prev = ((0, 0), (1, 0), (0, 0), (0, 0), (0, 0), (0, 0))
    kcat = jnp.concatenate([jnp.pad(kb, pad_prev)[:, :nb], kb], axis=2)
    vcat = jnp.concatenate([jnp.pad(vb, pad_prev)[:, :nb], vb], axis=2)
    scores = jnp.einsum("bnqrhe,bnkrhe->bnrhqk", qb, kcat) * (1.0 / math.sqrt(e))
    qi = jnp.arange(blk)[:, None]
    ki = jnp.arange(2 * blk)[None, :]
    dist = qi + blk - ki
    in_band = (dist >= 0) & (dist <= span)
    key_u = jnp.arange(nb)[:, None] * blk - blk + jnp.arange(2 * blk)[None, :]
    valid = in_band[None] & (key_u >= 0)[:, None, :]
    bias = -slopes[:, None, None] * (dilation * dist).astype(f32)[None]
    logits = jnp.where(valid[None, :, None, None], scores + bias[None, None, None], -jnp.inf)
    lse = jax.nn.logsumexp(logits, axis=-1)
    probs = jnp.exp(logits - lse[..., None])
    out = jnp.einsum("bnrhqk,bnkrhe->bnqrhe", probs, vcat)
    out = out.reshape(b, lp, dilation, nh, e)[:, :lu].reshape(b, t, nh, e)
    lse = lse.transpose(0, 1, 4, 2, 3).reshape(b, lp, dilation, nh)[:, :lu].reshape(b, t, nh)
    return out, lse


def dilated_attention_mixer(h, w_qkv, q_gain, k_gain, w_o):
    b, t, _ = h.shape
    qkv = (h @ w_qkv.astype(h.dtype)).reshape(b, t, N_DIL_GROUPS, 3, ATT_HEADS, ATT_HEAD_DIM)
    q = rmsnorm(qkv[:, :, :, 0], q_gain)
    k = rmsnorm(qkv[:, :, :, 1], k_gain)
    v = qkv[:, :, :, 2]
    slopes = alibi_slopes(ATT_HEADS)
    outs, lses = [], []
    for g, (window, dilation) in enumerate(DIL_PATTERNS):
        o_g, l_g = dilated_group_attention(q[:, :, g], k[:, :, g], v[:, :, g], window, dilation, slopes)
        outs.append(o_g)
        lses.append(l_g)
    alpha = jax.nn.softmax(jnp.stack(lses), axis=0)
    o = jnp.einsum("gbth,gbthe->bthe", alpha, jnp.stack(outs))
    return o.reshape(b, t, ATT_HEADS * ATT_HEAD_DIM).astype(h.dtype) @ w_o.astype(h.dtype)


def swiglu(h, w_gate, w_up, w_down):
    return (jax.nn.silu(h @ w_gate.astype(h.dtype)) * (h @ w_up.astype(h.dtype))) @ w_down.astype(h.dtype)


def setup_inputs(seed: int = 0) -> dict:
    key = jax.random.key(seed)
    ks = jax.random.split(key, 24)
    f32 = jnp.float32

    def nrm(k, shape, scale):
        return jax.random.normal(k, shape, f32) * scale

    nm, na = N_MAMBA_LAYERS, N_ATTN_LAYERS
    dt0 = jnp.exp(jax.random.uniform(ks[8], (nm, SSM_HEADS), f32, math.log(1e-3), math.log(1e-1)))
    return {
        "x": nrm(ks[0], (BATCH, SEQ, D_MODEL), 1.0),
        "p": nrm(ks[1], (DEPTH, BATCH, SEQ, PLE_DIM), 1.0),
        "norm_mix": 1.0 + nrm(ks[2], (DEPTH, D_MODEL), 0.02),
        "norm_ffn": 1.0 + nrm(ks[3], (DEPTH, D_MODEL), 0.02),
        "ssm_w_in": nrm(ks[4], (nm, D_MODEL, IN_PROJ_DIM), D_MODEL ** -0.5),
        "ssm_conv_w": nrm(ks[5], (nm, CONV_WIDTH, CONV_DIM), CONV_WIDTH ** -0.5),
        "ssm_conv_b": nrm(ks[6], (nm, CONV_DIM), 0.02),
        "ssm_dt_bias": dt0 + jnp.log(-jnp.expm1(-dt0)),
        "ssm_a_log": jnp.log(jax.random.uniform(ks[9], (nm, SSM_HEADS), f32, 1.0, 16.0)),
        "ssm_d_skip": 1.0 + nrm(ks[10], (nm, SSM_HEADS), 0.1),
        "ssm_norm_w": 1.0 + nrm(ks[11], (nm, D_INNER), 0.02),
        "ssm_w_out": nrm(ks[12], (nm, D_INNER, D_MODEL), D_INNER ** -0.5),
        "att_w_qkv": nrm(ks[13], (na, D_MODEL, QKV_DIM), D_MODEL ** -0.5),
        "att_q_norm": 1.0 + nrm(ks[14], (na, ATT_HEAD_DIM), 0.02),
        "att_k_norm": 1.0 + nrm(ks[15], (na, ATT_HEAD_DIM), 0.02),
        "att_w_o": nrm(ks[16], (na, ATT_HEADS * ATT_HEAD_DIM, D_MODEL), (ATT_HEADS * ATT_HEAD_DIM) ** -0.5),
        "ffn_w_gate": nrm(ks[17], (DEPTH, D_MODEL, FFN_HIDDEN), D_MODEL ** -0.5),
        "ffn_w_up": nrm(ks[18], (DEPTH, D_MODEL, FFN_HIDDEN), D_MODEL ** -0.5),
        "ffn_w_down": nrm(ks[19], (DEPTH, FFN_HIDDEN, D_MODEL), FFN_HIDDEN ** -0.5),
        "ple_w_proj": nrm(ks[20], (DEPTH, PLE_DIM, D_MODEL), PLE_DIM ** -0.5),
        "ple_w_gate": nrm(ks[21], (DEPTH, D_MODEL, D_MODEL), D_MODEL ** -0.5),
    }


def reference(x, p, norm_mix, norm_ffn, ssm_w_in, ssm_conv_w, ssm_conv_b, ssm_dt_bias,
              ssm_a_log, ssm_d_skip, ssm_norm_w, ssm_w_out, att_w_qkv, att_q_norm,
              att_k_norm, att_w_o, ffn_w_gate, ffn_w_up, ffn_w_down, ple_w_proj, ple_w_gate):
    for i in range(DEPTH):
        j = i // N_MIXERS
        h = rmsnorm(x, norm_mix[i])
        if i % N_MIXERS == 0:
            mix = mamba2_mixer(h, ssm_w_in[j], ssm_conv_w[j], ssm_conv_b[j], ssm_dt_bias[j],
                               ssm_a_log[j], ssm_d_skip[j], ssm_norm_w[j], ssm_w_out[j])
        else:
            mix = dilated_attention_mixer(h, att_w_qkv[j], att_q_norm[j], att_k_norm[j], att_w_o[j])
        x = x + mix.astype(x.dtype)
        x = x + swiglu(rmsnorm(x, norm_ffn[i]), ffn_w_gate[i], ffn_w_up[i], ffn_w_down[i]).astype(x.dtype)
        gate = jax.nn.sigmoid((x @ ple_w_gate[i].astype(x.dtype)).astype(jnp.float32))
        ple = (p[i].astype(x.dtype) @ ple_w_proj[i].astype(x.dtype)).astype(jnp.float32)
        x = x + (gate * ple).astype(x.dtype)
    return x
```

```cpp
#include <hip/hip_runtime.h>
#include <cstdio>
#include <cstdint>

#ifndef DUP_PHASE
#define DUP_PHASE 0
#define DUP_N 0
#endif

#define LAS __attribute__((address_space(3)))
#define GAS __attribute__((address_space(1)))
typedef unsigned short bf16_t;
typedef short bf16x8 __attribute__((ext_vector_type(8)));
typedef float f32x4 __attribute__((ext_vector_type(4)));
typedef float f32x2 __attribute__((ext_vector_type(2)));
typedef unsigned u32x4 __attribute__((ext_vector_type(4)));
typedef unsigned u32x2 __attribute__((ext_vector_type(2)));
typedef __bf16 bf16x2_t __attribute__((ext_vector_type(2)));
typedef float f32x16_ __attribute__((ext_vector_type(16)));
typedef float f32x16 __attribute__((ext_vector_type(16)));
typedef short s16x4 __attribute__((ext_vector_type(4)));
typedef short v4i16_t __attribute__((ext_vector_type(4)));

constexpr int M_ = 16384, D_ = 1024, T_ = 4096, NB_ = 4;
constexpr int DIN = 2048, XBC = 3072, INP = 5152;
constexpr int FF = 2816, PLED = 256;
constexpr int QG = 3072, QKVD = 9216;
constexpr float EPS = 1e-6f;
constexpr float LOG2E = 1.4426950408889634f;
constexpr float QSCALE = 0.125f * LOG2E;
constexpr int NWAVES = 8, NTHREADS = 512;

constexpr size_t MiB = 1u << 20;
constexpr size_t WS_CTL = 0, CTL_ZERO_BYTES = 64 * 1024;
constexpr size_t WS_SS = 1 * MiB;
constexpr size_t WS_DT = 2 * MiB;
constexpr size_t WS_GN = 4 * MiB;
constexpr size_t WS_LSE = 6 * MiB;
constexpr size_t WS_WDT = 7 * MiB;
constexpr size_t WS_W = 8 * MiB;
constexpr size_t W_XBC = WS_W;
constexpr size_t W_Z = W_XBC + (size_t)3072 * 1024 * 2;
constexpr size_t W_OUT = W_Z + (size_t)2048 * 1024 * 2;
constexpr size_t W_GU0 = W_OUT + (size_t)1024 * 2048 * 2;
constexpr size_t W_D0 = W_GU0 + (size_t)5632 * 1024 * 2;
constexpr size_t W_PG0 = W_D0 + (size_t)1024 * 2816 * 2;
constexpr size_t W_PP0 = W_PG0 + (size_t)1024 * 1024 * 2;
constexpr size_t W_GU1 = W_PP0 + (size_t)1024 * 256 * 2;
constexpr size_t W_D1 = W_GU1 + (size_t)5632 * 1024 * 2;
constexpr size_t W_QKV = W_D1 + (size_t)1024 * 2816 * 2;
constexpr size_t W_O = W_QKV + (size_t)9216 * 1024 * 2;
constexpr size_t W_PG1 = W_O + (size_t)1024 * 1024 * 2;
constexpr size_t W_PP1 = W_PG1 + (size_t)1024 * 1024 * 2;
constexpr size_t W_END = W_PP1 + (size_t)1024 * 256 * 2;
static_assert(W_GU1 >= 40 * MiB, "layer-0 weights must cover the V buffer");
static_assert(W_END == 80 * MiB, "weight map");
constexpr size_t WS_XB = 80 * MiB;
constexpr size_t WS_BIG = 112 * MiB;
constexpr size_t WS_AUX = 208 * MiB;
constexpr size_t WS_PB = 240 * MiB;
constexpr size_t WS_END = 256 * MiB;

struct QKVSet { bf16_t* q; bf16_t* k; bf16_t* v; };
__device__ __forceinline__ QKVSet qkv_set(unsigned char* ws, float* out, int which) {
    QKVSet r;
    if (which == 0) { bf16_t* B = (bf16_t*)(ws + WS_BIG); r.q = B; r.k = B + (size_t)16 * MiB; r.v = B + (size_t)32 * MiB; }
    else { r.q = (bf16_t*)(ws + WS_XB); r.k = (bf16_t*)out + (size_t)16 * MiB; r.v = (bf16_t*)(ws + WS_W); }
    return r;
}

__device__ __forceinline__ unsigned cvtpk(float lo, float hi) { f32x2 v = {lo, hi}; bf16x2_t b = __builtin_convertvector(v, bf16x2_t); return __builtin_bit_cast(unsigned, b); }
__device__ __forceinline__ float bflo(unsigned w) { return __uint_as_float(w << 16); }
__device__ __forceinline__ float bfhi(unsigned w) { return __uint_as_float(w & 0xffff0000u); }
__device__ __forceinline__ float fast_exp2(float x) { return __builtin_amdgcn_exp2f(x); }
__device__ __forceinline__ float fast_rcp(float x) { return __builtin_amdgcn_rcpf(x); }
__device__ __forceinline__ float sigmoidf_(float x) { return fast_rcp(1.f + fast_exp2(-x * LOG2E)); }
__device__ __forceinline__ float siluf_(float x) { return x * sigmoidf_(x); }
__device__ __forceinline__ float wave_sum(float v) {
#pragma unroll
    for (int o = 1; o < 64; o <<= 1) v += __shfl_xor(v, o);
    return v;
}
__device__ __forceinline__ float rstd_ss(const float* SS, int row) {
    const f32x4* p = (const f32x4*)(SS + (size_t)row * 16);
    const f32x4 a = p[0], b = p[1], c = p[2], d = p[3];
    const float s = ((a.x + a.y) + (a.z + a.w)) + ((b.x + b.y) + (b.z + b.w)) + ((c.x + c.y) + (c.z + c.w)) + ((d.x + d.y) + (d.z + d.w));
    return rsqrtf(s * (1.f / 1024.f) + EPS);
}
#define LDS_WAIT() asm volatile("s_waitcnt lgkmcnt(0)" ::: "memory")
__device__ __forceinline__ unsigned off_b(unsigned row, unsigned ch) { return 256u * row + 16u * (ch ^ (((row & 3) << 2) | ((row >> 2) & 3))); }

namespace pg8 {
constexpr int BM = 256, BK = 64, HALF = 128, HTB = HALF * BK * 2, STAGE_BYTES = 8 * HTB, NXCD = 8, WGM = 8;
__host__ __device__ __forceinline__ int lds_byte(int r, int c) { const int st = (r >> 4) * 2 + (c >> 5), rr = r & 15, cc = c & 31, ob = rr * 64 + cc * 2; return st * 1024 + (ob ^ (((ob >> 9) & 1) << 5)); }
__host__ __device__ __forceinline__ void stage_rc(int b, int& R, int& C) { const int st = b / 1024, sb = b % 1024, swz = sb ^ (((sb >> 9) & 1) << 5); R = (st >> 1) * 16 + swz / 64; C = (st & 1) * 32 + (swz % 64) / 2; }
__host__ __device__ __forceinline__ int perm32(int rho) { const int n = rho >> 4, i = rho & 15; return 8 * (i >> 2) + 4 * n + (i & 3); }

struct Unit { int pm, pn; };
struct Gemm { const bf16_t* A; const bf16_t* Bt; int M, N, K, lda; };

struct StaticOrder {
    int nM, nN, nwg, G, c;
    __host__ __device__ void init(int M, int N, int G_, int c_) { nM = M / BM; nN = N / BM; nwg = nM * nN; G = G_; c = c_; }
    __host__ __device__ bool next(int i, Unit& u) const {
        const long L = (long)i * G + c; if (L >= nwg) return false;
        int wgid = (int)L; { const int q = nwg / NXCD, r = nwg % NXCD, xcd = wgid % NXCD, off = wgid / NXCD; wgid = (xcd < r ? xcd * (q + 1) : r * (q + 1) + (xcd - r) * q) + off; }
        const int nig = WGM * nN, gid = wgid / nig, fm = gid * WGM, gsz = (nM - fm) < WGM ? (nM - fm) : WGM;
        u.pm = fm + ((wgid % nig) % gsz); u.pn = (wgid % nig) / gsz; return true;
    }
};

template <class Epi, class Sched, bool ALIGN_EPI = true, bool SP2 = true>
__device__ __forceinline__ void gemm_phase(LAS unsigned char* lds, const int tid, const Gemm g, const Sched& S, const Epi& E) {
    const int wid = __builtin_amdgcn_readfirstlane(tid >> 6), lane = tid & 63, wr = wid >> 2, wc = wid & 3, fr = lane & 15, fq = lane >> 4;
    const int K = g.K, nt = K / BK, lda = g.lda;
    unsigned voffA[2], voffB[2];
#pragma unroll
    for (int i = 0; i < 2; ++i) { int R, C; stage_rc(tid * 16 + i * 8192, R, C); const int Rb = Epi::PERM ? ((R & ~31) + perm32(R & 31)) : R;
        voffA[i] = (unsigned)(R * lda + C) * 2u; voffB[i] = (unsigned)(Rb * K + C) * 2u; }
    const size_t kstep = (size_t)(BK * 2);
    const size_t hstepA = (size_t)HALF * lda * 2, hstepB = (size_t)HALF * K * 2;
    const size_t tstepA = 2 * hstepA, tstepB = 2 * hstepB;
    const unsigned ldsw = (unsigned)wid * 1024u;
    const int aoff = lds_byte(wr * 64 + fr, fq * 8), boff = lds_byte(wc * 32 + fr, fq * 8);
#define PG8_SA(b, h) (((b) * 2 + (h)) * HTB)
#define PG8_SB(b, h) ((4 + (b) * 2 + (h)) * HTB)
#define PG8_STAGE(bufoff, gbase, voff) do { _Pragma("unroll") for (int _i = 0; _i < 2; ++_i) \
        __builtin_amdgcn_global_load_lds((const unsigned*)((const char*)(gbase) + (voff)[_i]), (LAS unsigned*)(lds + (bufoff) + ldsw + _i * 8192), 16, 0, 0); } while (0)
#define PG8_LDA(dst, b, h) do { _Pragma("unroll") for (int m = 0; m < 4; ++m) _Pragma("unroll") for (int k = 0; k < 2; ++k) dst[m][k] = *(const LAS bf16x8*)(lds + PG8_SA(b, h) + aoff + m * 2048 + k * 1024); } while (0)
#define PG8_LDB(dst, b, h) do { _Pragma("unroll") for (int n = 0; n < 2; ++n) _Pragma("unroll") for (int k = 0; k < 2; ++k) dst[n][k] = *(const LAS bf16x8*)(lds + PG8_SB(b, h) + boff + n * 2048 + k * 1024); } while (0)
#define PG8_MMA(ai, bj, At, Bt) do { __builtin_amdgcn_s_setprio(1); _Pragma("unroll") for (int m = 0; m < 4; ++m) _Pragma("unroll") for (int n = 0; n < 2; ++n) _Pragma("unroll") for (int k = 0; k < 2; ++k) \
        acc[ai][bj][m][n] = __builtin_amdgcn_mfma_f32_16x16x32_bf16(Bt[n][k], At[m][k], acc[ai][bj][m][n], 0, 0, 0); __builtin_amdgcn_s_setprio(0); } while (0)
#define PG8_WAIT_V(n) asm volatile("s_waitcnt vmcnt(" #n ")" ::: "memory")
#define PG8_WAIT_L(n) asm volatile("s_waitcnt lgkmcnt(" #n ")" ::: "memory")
#define PG8_BAR __builtin_amdgcn_s_barrier()
#define PG8_SCHED __builtin_amdgcn_sched_barrier(0)
    Unit cur, nxt; int ui = 0;
    if (!S.next(0, cur)) return;
    f32x4 acc[2][2][4][2];
#pragma unroll
    for (int a = 0; a < 2; ++a)
#pragma unroll
        for (int b = 0; b < 2; ++b)
#pragma unroll
            for (int m = 0; m < 4; ++m)
#pragma unroll
                for (int n = 0; n < 2; ++n) acc[a][b][m][n] = (f32x4){0.f, 0.f, 0.f, 0.f};
    bf16x8 At[4][2], B0[2][2], B1[2][2];
    const char* cA = (const char*)g.A + (size_t)cur.pm * tstepA; const char* cB = (const char*)g.Bt + (size_t)cur.pn * tstepB;
    if constexpr (Epi::SEG) E.unit_begin(cur, ui, tid);
    if constexpr (SP2) {
        PG8_STAGE(PG8_SB(0, 0), cB, voffB); PG8_STAGE(PG8_SB(0, 1), cB + hstepB, voffB); PG8_STAGE(PG8_SA(0, 0), cA, voffA); PG8_STAGE(PG8_SA(0, 1), cA + hstepA, voffA);
        if (wr == 1) PG8_BAR;
        PG8_WAIT_V(2); PG8_BAR;
        PG8_STAGE(PG8_SB(1, 0), cB + kstep, voffB); PG8_STAGE(PG8_SA(1, 0), cA + kstep, voffA); PG8_STAGE(PG8_SB(1, 1), cB + hstepB + kstep, voffB);
        PG8_WAIT_V(6); PG8_BAR;
    } else {
        PG8_STAGE(PG8_SB(0, 0), cB, voffB); PG8_STAGE(PG8_SA(0, 0), cA, voffA); PG8_STAGE(PG8_SB(0, 1), cB + hstepB, voffB); PG8_STAGE(PG8_SA(0, 1), cA + hstepA, voffA);
        if (wr == 1) PG8_BAR;
        PG8_WAIT_V(4); PG8_BAR;
        PG8_STAGE(PG8_SB(1, 0), cB + kstep, voffB); PG8_STAGE(PG8_SA(1, 0), cA + kstep, voffA); PG8_STAGE(PG8_SB(1, 1), cB + hstepB + kstep, voffB);
        PG8_WAIT_V(6); PG8_BAR;
    }
    for (;;) {
        const bool has_next = S.next(ui + 1, nxt);
        const char* nA = has_next ? (const char*)g.A + (size_t)nxt.pm * tstepA : cA; const char* nB = has_next ? (const char*)g.Bt + (size_t)nxt.pn * tstepB : cB;
#pragma clang loop unroll(disable)
        for (int t = 0; t < nt; t += 2) {
            if constexpr (Epi::SEG) { if (t && (t & 7) == 0) { PG8_SCHED; E.seg_scale(acc, (t >> 3) - 1, ui, wr, fr); PG8_SCHED; } }
            const bool last = (t == nt - 2);
            const char* a1 = cA + (size_t)(t + 1) * kstep;
            const char* a2 = last ? nA : cA + (size_t)(t + 2) * kstep; const char* b2 = last ? nB : cB + (size_t)(t + 2) * kstep;
            const char* a3 = a2 + kstep; const char* b3 = b2 + kstep;
            if constexpr (SP2) {
            PG8_LDB(B0, 0, 0); PG8_LDB(B1, 0, 1); PG8_SCHED; PG8_LDA(At, 0, 0); PG8_STAGE(PG8_SA(1, 1), a1 + hstepA, voffA);
            PG8_WAIT_V(8); PG8_WAIT_L(0); PG8_BAR; PG8_MMA(0, 0, At, B0); PG8_MMA(0, 1, At, B1); PG8_BAR; PG8_SCHED;
            PG8_LDA(At, 0, 1); PG8_STAGE(PG8_SB(0, 0), b2, voffB); PG8_STAGE(PG8_SB(0, 1), b2 + hstepB, voffB); PG8_STAGE(PG8_SA(0, 0), a2, voffA);
            PG8_WAIT_V(8); PG8_WAIT_L(0); PG8_BAR; PG8_MMA(1, 0, At, B0); PG8_MMA(1, 1, At, B1); PG8_BAR; PG8_SCHED;
            PG8_LDB(B0, 1, 0); PG8_LDB(B1, 1, 1); PG8_SCHED; PG8_LDA(At, 1, 0); PG8_STAGE(PG8_SA(0, 1), a2 + hstepA, voffA);
            PG8_WAIT_V(8); PG8_WAIT_L(0); PG8_BAR; PG8_MMA(0, 0, At, B0); PG8_MMA(0, 1, At, B1); PG8_BAR; PG8_SCHED;
            PG8_LDA(At, 1, 1); PG8_STAGE(PG8_SB(1, 0), b3, voffB); PG8_STAGE(PG8_SB(1, 1), b3 + hstepB, voffB); PG8_STAGE(PG8_SA(1, 0), a3, voffA);
            PG8_WAIT_V(8); PG8_WAIT_L(0); PG8_BAR; PG8_MMA(1, 0, At, B0); PG8_MMA(1, 1, At, B1); PG8_BAR; PG8_SCHED;
            } else {
            PG8_LDB(B0, 0, 0); PG8_SCHED; PG8_LDA(At, 0, 0); PG8_STAGE(PG8_SA(1, 1), a1 + hstepA, voffA);
            PG8_WAIT_L(8); PG8_BAR; PG8_WAIT_L(0); PG8_MMA(0, 0, At, B0); PG8_BAR; PG8_SCHED;
            PG8_LDB(B1, 0, 1); PG8_STAGE(PG8_SB(0, 0), b2, voffB);
            PG8_BAR; PG8_WAIT_L(0); PG8_MMA(0, 1, At, B1); PG8_BAR;
            PG8_LDA(At, 0, 1); PG8_STAGE(PG8_SA(0, 0), a2, voffA);
            PG8_BAR; PG8_WAIT_L(0); PG8_MMA(1, 0, At, B0); PG8_BAR; PG8_SCHED;
            PG8_STAGE(PG8_SB(0, 1), b2 + hstepB, voffB);
            PG8_WAIT_V(6); PG8_BAR; PG8_MMA(1, 1, At, B1); PG8_BAR;
            PG8_LDB(B0, 1, 0); PG8_SCHED; PG8_LDA(At, 1, 0); PG8_STAGE(PG8_SA(0, 1), a2 + hstepA, voffA);
            PG8_WAIT_L(8); PG8_BAR; PG8_WAIT_L(0); PG8_MMA(0, 0, At, B0); PG8_BAR; PG8_SCHED;
            PG8_LDB(B1, 1, 1); PG8_STAGE(PG8_SB(1, 0), b3, voffB);
            PG8_BAR; PG8_WAIT_L(0); PG8_MMA(0, 1, At, B1); PG8_BAR;
            PG8_LDA(At, 1, 1); PG8_STAGE(PG8_SA(1, 0), a3, voffA);
            PG8_BAR; PG8_WAIT_L(0); PG8_MMA(1, 0, At, B0); PG8_BAR; PG8_SCHED;
            PG8_STAGE(PG8_SB(1, 1), b3 + hstepB, voffB);
            PG8_WAIT_V(6); PG8_BAR; PG8_MMA(1, 1, At, B1); PG8_BAR;
            }
        }
        if constexpr (ALIGN_EPI) { if (wr == 0) PG8_BAR; }
        if constexpr (Epi::SEG) { PG8_SCHED; E.seg_scale(acc, 3, ui, wr, fr); PG8_SCHED; }
        E(acc, cur, wr, wc, fr, fq);
        if (!has_next) break;
#pragma unroll
        for (int a = 0; a < 2; ++a)
#pragma unroll
            for (int b = 0; b < 2; ++b)
#pragma unroll
                for (int m = 0; m < 4; ++m)
#pragma unroll
                    for (int n = 0; n < 2; ++n) acc[a][b][m][n] = (f32x4){0.f, 0.f, 0.f, 0.f};
        cur = nxt; cA = nA; cB = nB; ++ui;
        if constexpr (Epi::SEG) E.unit_begin(cur, ui, tid);
        if constexpr (ALIGN_EPI) { if (wr == 1) PG8_BAR; }
    }
    PG8_WAIT_V(0);
    if constexpr (!ALIGN_EPI) { if (wr == 0) PG8_BAR; }
    PG8_BAR;
#undef PG8_SA
#undef PG8_SB
#undef PG8_STAGE
#undef PG8_LDA
#undef PG8_LDB
#undef PG8_MMA
#undef PG8_WAIT_V
#undef PG8_WAIT_L
#undef PG8_BAR
#undef PG8_SCHED
}

typedef f32x4 Acc[2][2][4][2];
__device__ __forceinline__ void rs_fill(const float* SS, int pm, LAS float* tab, int wr, int wc, int fr, int fq) {
    const int tid = (wr * 4 + wc) * 64 + fq * 16 + fr;
    if (tid < 256) tab[tid] = rstd_ss(SS, pm * BM + tid);
    asm volatile("s_waitcnt lgkmcnt(0)" ::: "memory");
    __builtin_amdgcn_s_barrier();
    asm volatile("" ::: "memory");
}

struct EpiStore {
    static constexpr bool PERM = true, SEG = false;
    bf16_t* O; int ldc; const float* SS; LAS float* tab;
    __device__ __forceinline__ void operator()(const Acc& acc, const Unit& u, int wr, int wc, int fr, int fq) const {
        if (SS) rs_fill(SS, u.pm, tab, wr, wc, fr, fq);
#pragma unroll
        for (int ai = 0; ai < 2; ++ai)
#pragma unroll
            for (int m = 0; m < 4; ++m) {
                const int row = u.pm * BM + ai * HALF + wr * 64 + m * 16 + fr;
                const float rs = SS ? tab[ai * HALF + wr * 64 + m * 16 + fr] : 1.f;
                bf16_t* rowp = O + (size_t)row * ldc + u.pn * BM + wc * 32 + 8 * fq;
#pragma unroll
                for (int bj = 0; bj < 2; ++bj) {
                    const f32x4 v0 = acc[ai][bj][m][0] * rs, v1 = acc[ai][bj][m][1] * rs;
                    u32x4 w; w.x = cvtpk(v0[0], v0[1]); w.y = cvtpk(v0[2], v0[3]); w.z = cvtpk(v1[0], v1[1]); w.w = cvtpk(v1[2], v1[3]);
                    *(u32x4*)(rowp + bj * HALF) = w;
                }
                asm volatile("" ::: "memory");
            }
    }
};
struct EpiZ {
    static constexpr bool PERM = true, SEG = false;
    bf16_t* Y; const float* SS; float* GN; LAS float* tab;
    __device__ __forceinline__ void operator()(const Acc& acc, const Unit& u, int wr, int wc, int fr, int fq) const {
        rs_fill(SS, u.pm, tab, wr, wc, fr, fq);
#pragma unroll
        for (int ai = 0; ai < 2; ++ai)
#pragma unroll
            for (int m = 0; m < 4; ++m) {
                const int row = u.pm * BM + ai * HALF + wr * 64 + m * 16 + fr;
                const float rs = tab[ai * HALF + wr * 64 + m * 16 + fr];
                bf16_t* rowp = Y + (size_t)row * XBC + u.pn * BM + wc * 32 + 8 * fq;
                float ssum = 0.f;
#pragma unroll
                for (int bj = 0; bj < 2; ++bj) {
                    const u32x4 yv = *(const u32x4*)(rowp + bj * HALF);
                    const f32x4 z0 = acc[ai][bj][m][0] * rs, z1 = acc[ai][bj][m][1] * rs;
                    float o[8];
                    o[0] = bflo(yv.x) * siluf_(z0[0]); o[1] = bfhi(yv.x) * siluf_(z0[1]); o[2] = bflo(yv.y) * siluf_(z0[2]); o[3] = bfhi(yv.y) * siluf_(z0[3]);
                    o[4] = bflo(yv.z) * siluf_(z1[0]); o[5] = bfhi(yv.z) * siluf_(z1[1]); o[6] = bflo(yv.w) * siluf_(z1[2]); o[7] = bfhi(yv.w) * siluf_(z1[3]);
#pragma unroll
                    for (int j = 0; j < 8; ++j) ssum += o[j] * o[j];
                    u32x4 w; w.x = cvtpk(o[0], o[1]); w.y = cvtpk(o[2], o[3]); w.z = cvtpk(o[4], o[5]); w.w = cvtpk(o[6], o[7]);
                    *(u32x4*)(rowp + bj * HALF) = w;
                }
                ssum += __shfl_xor(ssum, 16); ssum += __shfl_xor(ssum, 32);
                if (fq == 0) GN[(size_t)row * 32 + u.pn * 4 + wc] = ssum;
                asm volatile("" ::: "memory");
            }
    }
};
template <bool GATE, bool FINAL, bool SEG_ = false> struct EpiRes {
    static constexpr bool PERM = true, SEG = SEG_;
    float* xout; const bf16_t* xin; bf16_t* xb; float* SS; const bf16_t* ple;
    const float* GN; LAS float* seg;
    __device__ __forceinline__ void unit_begin(const Unit& u, int ui, int tid) const {
        if (tid < 256) {
            const f32x4* gp = (const f32x4*)(GN + (size_t)(u.pm * BM + tid) * 32);
            float sg[4];
#pragma unroll
            for (int g = 0; g < 4; ++g) { const f32x4 a = gp[2 * g], b = gp[2 * g + 1]; asm volatile("" ::: "memory"); sg[g] = rsqrtf((((a[0] + a[1]) + (a[2] + a[3])) + ((b[0] + b[1]) + (b[2] + b[3]))) * (1.f / 512.f) + EPS); }
            f32x4 o; o[0] = sg[0] / sg[1]; o[1] = sg[1] / sg[2]; o[2] = sg[2] / sg[3]; o[3] = sg[3];
            *(LAS f32x4*)(seg + ((ui & 1) * 256 + tid) * 4) = o;
        }
    }
    __device__ __forceinline__ void seg_scale(Acc& acc, int sgi, int ui, int wr, int fr) const {
#pragma unroll
        for (int ai = 0; ai < 2; ++ai)
#pragma unroll
            for (int m = 0; m < 4; ++m) { const float f = seg[((ui & 1) * 256 + ai * HALF + wr * 64 + m * 16 + fr) * 4 + sgi];
#pragma unroll
                for (int bj = 0; bj < 2; ++bj)
#pragma unroll
                    for (int n = 0; n < 2; ++n) acc[ai][bj][m][n] *= f; }
    }
    __device__ __forceinline__ void operator()(const Acc& acc, const Unit& u, int wr, int wc, int fr, int fq) const {
#pragma unroll
        for (int ai = 0; ai < 2; ++ai)
#pragma unroll
            for (int m = 0; m < 4; ++m) {
                const int row = u.pm * BM + ai * HALF + wr * 64 + m * 16 + fr;
                const size_t rb = (size_t)row * D_ + u.pn * BM + wc * 32 + 8 * fq;
                float ssum = 0.f;
#pragma unroll
                for (int bj = 0; bj < 2; ++bj) {
                    const size_t off = rb + bj * HALF;
                    const u32x4 xo = *(const u32x4*)(xin + off);
                    f32x4 a0 = acc[ai][bj][m][0], a1 = acc[ai][bj][m][1];
                    if (GATE) { const u32x4 pv = *(const u32x4*)(ple + off);
                        a0[0] = sigmoidf_(a0[0]) * bflo(pv.x); a0[1] = sigmoidf_(a0[1]) * bfhi(pv.x); a0[2] = sigmoidf_(a0[2]) * bflo(pv.y); a0[3] = sigmoidf_(a0[3]) * bfhi(pv.y);
                        a1[0] = sigmoidf_(a1[0]) * bflo(pv.z); a1[1] = sigmoidf_(a1[1]) * bfhi(pv.z); a1[2] = sigmoidf_(a1[2]) * bflo(pv.w); a1[3] = sigmoidf_(a1[3]) * bfhi(pv.w); }
                    f32x4 x0, x1;
                    x0[0] = bflo(xo.x) + a0[0]; x0[1] = bfhi(xo.x) + a0[1]; x0[2] = bflo(xo.y) + a0[2]; x0[3] = bfhi(xo.y) + a0[3];
                    x1[0] = bflo(xo.z) + a1[0]; x1[1] = bfhi(xo.z) + a1[1]; x1[2] = bflo(xo.w) + a1[2]; x1[3] = bfhi(xo.w) + a1[3];
                    ssum += ((x0[0] * x0[0] + x0[1] * x0[1]) + (x0[2] * x0[2] + x0[3] * x0[3])) + ((x1[0] * x1[0] + x1[1] * x1[1]) + (x1[2] * x1[2] + x1[3] * x1[3]));
                    if (FINAL) { *(f32x4*)(xout + off) = x0; *(f32x4*)(xout + off + 4) = x1; }
                    else { u32x4 w; w.x = cvtpk(x0[0], x0[1]); w.y = cvtpk(x0[2], x0[3]); w.z = cvtpk(x1[0], x1[1]); w.w = cvtpk(x1[2], x1[3]); *(u32x4*)(xb + off) = w; }
                }
                ssum += __shfl_xor(ssum, 16); ssum += __shfl_xor(ssum, 32);
                if (SS && fq == 0) SS[(size_t)row * 16 + u.pn * 4 + wc] = ssum;
                if (m & 1) asm volatile("" ::: "memory");
            }
    }
};
struct EpiGU {
    static constexpr bool PERM = true, SEG = false;
    bf16_t* H; const float* SS; LAS float* tab;
    __device__ __forceinline__ void operator()(const Acc& acc, const Unit& u, int wr, int wc, int fr, int fq) const {
        rs_fill(SS, u.pm, tab, wr, wc, fr, fq);
#pragma unroll
        for (int ai = 0; ai < 2; ++ai)
#pragma unroll
            for (int m = 0; m < 4; ++m) {
                const int row = u.pm * BM + ai * HALF + wr * 64 + m * 16 + fr;
                const float rs = tab[ai * HALF + wr * 64 + m * 16 + fr];
                float o[8];
#pragma unroll
                for (int n = 0; n < 2; ++n) {
                    const f32x4 gq = acc[ai][0][m][n] * rs, uq = acc[ai][1][m][n] * rs;
#pragma unroll
                    for (int j = 0; j < 4; ++j) o[4 * n + j] = siluf_(gq[j]) * uq[j];
                }
                u32x4 w; w.x = cvtpk(o[0], o[1]); w.y = cvtpk(o[2], o[3]); w.z = cvtpk(o[4], o[5]); w.w = cvtpk(o[6], o[7]);
                *(u32x4*)(H + (size_t)row * FF + u.pn * HALF + wc * 32 + 8 * fq) = w;
                asm volatile("" ::: "memory");
            }
    }
};
struct EpiQKV {
    static constexpr bool PERM = true, SEG = false;
    bf16_t* Oq; long dk, dv; const float* SS; const float* qg; const float* kg; LAS float* tab;
    __device__ __forceinline__ void operator()(const Acc& acc, const Unit& u, int wr, int wc, int fr, int fq) const {
        const int tid = (wr * 4 + wc) * 64 + fq * 16 + fr;
        f32x4 s0, s1, s2, s3;
        if (tid < 256) { const f32x4* p = (const f32x4*)(SS + (size_t)(u.pm * BM + tid) * 16); s0 = p[0]; s1 = p[1]; s2 = p[2]; s3 = p[3]; }
        const int type = u.pn >> 2;
        bf16_t* O = Oq + ((type == 1) ? dk : (type == 2) ? dv : 0l);
        f32x4 gn[2][2];
        const float* gp = (type == 0) ? qg : kg;
#pragma unroll
        for (int bj = 0; bj < 2; ++bj)
#pragma unroll
            for (int n = 0; n < 2; ++n) gn[bj][n] = (type < 2) ? *(const f32x4*)(gp + 32 * bj + 8 * fq + 4 * n) : (f32x4){1.f, 1.f, 1.f, 1.f};
        float f[8];
        if (type < 2) {
#pragma unroll
            for (int i = 0; i < 8; ++i) { const int ai = i >> 2, m = i & 3; f32x4 q = acc[ai][0][m][0] * acc[ai][0][m][0];
                q += acc[ai][0][m][1] * acc[ai][0][m][1]; q += acc[ai][1][m][0] * acc[ai][1][m][0]; q += acc[ai][1][m][1] * acc[ai][1][m][1];
                f[i] = (q[0] + q[1]) + (q[2] + q[3]); }
#pragma unroll
            for (int i = 0; i < 8; ++i) f[i] += __shfl_xor(f[i], 16);
#pragma unroll
            for (int i = 0; i < 8; ++i) f[i] += __shfl_xor(f[i], 32);
        }
        if (tid < 256) { const float s = ((s0.x + s0.y) + (s0.z + s0.w)) + ((s1.x + s1.y) + (s1.z + s1.w)) + ((s2.x + s2.y) + (s2.z + s2.w)) + ((s3.x + s3.y) + (s3.z + s3.w));
            tab[tid] = rsqrtf(s * (1.f / 1024.f) + EPS); }
        asm volatile("s_waitcnt lgkmcnt(0)" ::: "memory");
        __builtin_amdgcn_s_barrier();
        asm volatile("" ::: "memory");
#pragma unroll
        for (int i = 0; i < 8; ++i) { const float rs = tab[(i >> 2) * HALF + wr * 64 + (i & 3) * 16 + fr];
            if (type < 2) { float rr = rs * rsqrtf(rs * rs * f[i] * (1.f / 64.f) + EPS); if (type == 0) rr *= QSCALE; f[i] = rr; } else f[i] = rs; }
#pragma unroll
        for (int ai = 0; ai < 2; ++ai)
#pragma unroll
            for (int m = 0; m < 4; ++m) {
                const int row = u.pm * BM + ai * HALF + wr * 64 + m * 16 + fr;
                const float rr = f[ai * 4 + m];
                bf16_t* rowp = O + (size_t)row * D_ + (u.pn & 3) * BM + wc * 64 + 8 * fq;
#pragma unroll
                for (int bj = 0; bj < 2; ++bj) {
                    const f32x4 v0 = acc[ai][bj][m][0] * gn[bj][0] * rr, v1 = acc[ai][bj][m][1] * gn[bj][1] * rr;
                    u32x4 w; w.x = cvtpk(v0[0], v0[1]); w.y = cvtpk(v0[2], v0[3]); w.z = cvtpk(v1[0], v1[1]); w.w = cvtpk(v1[2], v1[3]);
                    *(u32x4*)(rowp + bj * 32) = w;
                }
                if (m & 1) asm volatile("" ::: "memory");
            }
    }
};
}

#define XB_TMO      128
#define XB_XCNT(j)  (256  + 64 * (j))
#define XB_XSUB(j)  (1280 + 64 * (j))
#define XB_XGEN(j)  (2304 + 64 * (j))
#define XB_TOP      3328
#define XB_TOPGEN   3392
#define XCD_BAR_WORDS 3456
#define XB_SPIN_CAP (1u << 20)
__device__ __forceinline__ unsigned xb_ld(unsigned* p)              { return __hip_atomic_load(p, __ATOMIC_RELAXED, __HIP_MEMORY_SCOPE_AGENT); }
__device__ __forceinline__ unsigned xb_add(unsigned* p, unsigned v) { return __hip_atomic_fetch_add(p, v, __ATOMIC_RELAXED, __HIP_MEMORY_SCOPE_AGENT); }
__device__ __forceinline__ unsigned xb_xcc_id() { return (unsigned)__builtin_amdgcn_s_getreg((3 << 11) | 20) & 0xFu; }
#define XB_SPIN(cond, bar) do { unsigned _sp = 0; while (cond) { __builtin_amdgcn_s_sleep(1); \
    if ((++_sp & 255u) == 0u) { if (xb_ld(&(bar)[XB_TMO])) break; if (_sp > XB_SPIN_CAP) { atomicAdd(&(bar)[XB_TMO], 1u); break; } } } } while (0)
struct XcdBarrier { unsigned* bar; unsigned x; volatile LAS unsigned* st; };
__device__ __forceinline__ XcdBarrier xcd_barrier_post(unsigned* bar, volatile LAS unsigned* st) {
    XcdBarrier b; b.bar = bar; b.x = xb_xcc_id(); b.st = st;
    if (threadIdx.x == 0) (void)xb_add(&bar[XB_XCNT(b.x)], 1u);
    return b;
}
__device__ __forceinline__ void xcd_barrier_complete(unsigned* bar, unsigned x, unsigned& nloc, unsigned& nx) {
    const unsigned G = gridDim.x * gridDim.y * gridDim.z;
    unsigned sum, cnt, mine, sp = 0u;
    for (;;) {
        sum = 0u; cnt = 0u; mine = 0u;
#pragma unroll
        for (unsigned j = 0; j < 16; ++j) { const unsigned c = xb_ld(&bar[XB_XCNT(j)]); sum += c; cnt += (c > 0u) ? 1u : 0u; mine = (j == x) ? c : mine; }
        if (sum == G) break;
        __builtin_amdgcn_s_sleep(1);
        if ((++sp & 255u) == 0u) { if (xb_ld(&bar[XB_TMO])) break; if (sp > XB_SPIN_CAP) { atomicAdd(&bar[XB_TMO], 1u); break; } }
    }
    nloc = mine > 0u ? mine : 1u; nx = cnt > 0u ? cnt : 1u;
}
__device__ __forceinline__ void xcd_barrier(const XcdBarrier& b, unsigned& epoch) {
    asm volatile("s_waitcnt vmcnt(0)" ::: "memory");
    __syncthreads();
    if (threadIdx.x == 0) {
        unsigned* bar = b.bar;
        __builtin_amdgcn_s_waitcnt(0);
        unsigned nloc = b.st[0], nx = b.st[1];
        if (nloc == 0u) { xcd_barrier_complete(bar, b.x, nloc, nx); b.st[0] = nloc; b.st[1] = nx; }
        const unsigned old = xb_add(&bar[XB_XSUB(b.x)], 1u);
        if ((old + 1u) % nloc == 0u) {
            __builtin_amdgcn_fence(__ATOMIC_RELEASE, "agent");
            asm volatile("s_waitcnt vmcnt(0)" ::: "memory");
            const unsigned og = xb_add(&bar[XB_TOP], 1u);
            if ((og + 1u) % nx == 0u) xb_add(&bar[XB_TOPGEN], 1u);
        }
        XB_SPIN(xb_ld(&bar[XB_TOPGEN]) <= epoch, bar);
        __builtin_amdgcn_fence(__ATOMIC_ACQUIRE, "agent");
        asm volatile("s_waitcnt vmcnt(0)" ::: "memory");
    }
    ++epoch;
    __syncthreads();
}

constexpr int RING_BYTES = 131072;
constexpr int LDS_BYTES = 163840;
constexpr int LDSCTL_OFF = LDS_BYTES - 128, MISC_OFF = LDSCTL_OFF;

struct Args { const float* in[21]; float* out; unsigned char* ws; int ph_lo, ph_hi; };
enum { I_X = 0, I_P, I_NMIX, I_NFFN, I_WIN, I_CW, I_CB, I_DTB, I_ALOG, I_DSKIP, I_SNW, I_WOUT, I_WQKV, I_QN, I_KN, I_WO, I_FG, I_FU, I_FD, I_PP, I_PG };

struct Frame {
    LAS unsigned char* lds;
    int tid, lane, wave;
    const Args& a;
    __device__ __forceinline__ Frame(const Args& a_) : a(a_) {}
};

struct WDesc { const float* src; const float* src2; const float* gain; bf16_t* dst; int ld, K, nslots, mode, colbase; };
constexpr int NWMAT = 13;
__device__ __forceinline__ WDesc wdesc(const Frame& F, int mi) {
    WDesc w; w.src2 = nullptr; w.gain = nullptr; w.mode = 0; w.colbase = 0;
    unsigned char* ws = F.a.ws;
    switch (mi) {
    case 0: w.src = F.a.in[I_WIN]; w.ld = INP; w.K = 1024; w.nslots = 3072; w.colbase = 2048; w.gain = F.a.in[I_NMIX]; w.dst = (bf16_t*)(ws + W_XBC); break;
    case 1: w.src = F.a.in[I_WIN]; w.ld = INP; w.K = 1024; w.nslots = 2048; w.colbase = 0; w.gain = F.a.in[I_NMIX]; w.dst = (bf16_t*)(ws + W_Z); break;
    case 2: w.src = F.a.in[I_WOUT]; w.ld = 1024; w.K = 2048; w.nslots = 1024; w.gain = F.a.in[I_SNW]; w.dst = (bf16_t*)(ws + W_OUT); break;
    case 3: w.src = F.a.in[I_FG]; w.src2 = F.a.in[I_FU]; w.ld = FF; w.K = 1024; w.nslots = 5632; w.mode = 1; w.gain = F.a.in[I_NFFN]; w.dst = (bf16_t*)(ws + W_GU0); break;
    case 4: w.src = F.a.in[I_FG] + (size_t)1024 * FF; w.src2 = F.a.in[I_FU] + (size_t)1024 * FF; w.ld = FF; w.K = 1024; w.nslots = 5632; w.mode = 1; w.gain = F.a.in[I_NFFN] + 1024; w.dst = (bf16_t*)(ws + W_GU1); break;
    case 5: w.src = F.a.in[I_FD]; w.ld = 1024; w.K = FF; w.nslots = 1024; w.dst = (bf16_t*)(ws + W_D0); break;
    case 6: w.src = F.a.in[I_FD] + (size_t)FF * 1024; w.ld = 1024; w.K = FF; w.nslots = 1024; w.dst = (bf16_t*)(ws + W_D1); break;
    case 7: w.src = F.a.in[I_WQKV]; w.ld = QKVD; w.K = 1024; w.nslots = QKVD; w.mode = 2; w.gain = F.a.in[I_NMIX] + 1024; w.dst = (bf16_t*)(ws + W_QKV); break;
    case 8: w.src = F.a.in[I_WO]; w.ld = 1024; w.K = 1024; w.nslots = 1024; w.dst = (bf16_t*)(ws + W_O); break;
    case 9: w.src = F.a.in[I_PG]; w.ld = 1024; w.K = 1024; w.nslots = 1024; w.dst = (bf16_t*)(ws + W_PG0); break;
    case 10: w.src = F.a.in[I_PG] + (size_t)1024 * 1024; w.ld = 1024; w.K = 1024; w.nslots = 1024; w.dst = (bf16_t*)(ws + W_PG1); break;
    case 11: w.src = F.a.in[I_PP]; w.ld = 1024; w.K = 256; w.nslots = 1024; w.dst = (bf16_t*)(ws + W_PP0); break;
    default: w.src = F.a.in[I_PP] + (size_t)256 * 1024; w.ld = 1024; w.K = 256; w.nslots = 1024; w.dst = (bf16_t*)(ws + W_PP1); break;
    }
    return w;
}
__device__ __forceinline__ void cvt_item(const WDesc& w, int item, LAS float* scr, int lane) {
    const int nkb = w.K / 64, sb = item / nkb, kb = item % nkb, slot0 = sb * 32, k0 = kb * 64;
    const float* src = w.src; int col0;
    if (w.mode == 0) col0 = w.colbase + slot0;
    else if (w.mode == 1) { const int tile = slot0 >> 8, t = slot0 & 255; if (t < 128) col0 = tile * 128 + t; else { src = w.src2; col0 = tile * 128 + t - 128; } }
    else { const int g = slot0 / QG, r = slot0 % QG, tile = r >> 8, t = r & 255, bj = t >> 7, wc = (t & 127) >> 5; col0 = g * QG + tile * 256 + 64 * wc + 32 * bj; }
    float tv[32];
#pragma unroll
    for (int i = 0; i < 32; ++i) { const int kk = 2 * i + (lane >> 5); tv[i] = src[(size_t)(k0 + kk) * w.ld + col0 + (lane & 31)]; }
    if (w.gain) {
#pragma unroll
        for (int i = 0; i < 32; ++i) tv[i] *= w.gain[k0 + 2 * i + (lane >> 5)];
    }
#pragma unroll
    for (int i = 0; i < 32; ++i) scr[(2 * i + (lane >> 5)) * 33 + (lane & 31)] = tv[i];
    LDS_WAIT(); asm volatile("" ::: "memory");
    const int c = lane & 7;
#pragma unroll
    for (int j = 0; j < 4; ++j) { const int n = (lane >> 3) + 8 * j; const LAS float* s = scr + (8 * c) * 33 + n;
        u32x4 o; o.x = cvtpk(s[0 * 33], s[1 * 33]); o.y = cvtpk(s[2 * 33], s[3 * 33]); o.z = cvtpk(s[4 * 33], s[5 * 33]); o.w = cvtpk(s[6 * 33], s[7 * 33]);
        *(u32x4*)(w.dst + (size_t)(slot0 + n) * w.K + k0 + 8 * c) = o; }
    LDS_WAIT(); asm volatile("" ::: "memory");
}
__device__ __forceinline__ void cvt_flat(const Frame& F, const float* src, bf16_t* dst, size_t n8, int first_bid = 0) {
    if ((int)blockIdx.x < first_bid) return;
    for (size_t i = (size_t)((int)blockIdx.x - first_bid) * NTHREADS + F.tid; i < n8; i += (size_t)((int)gridDim.x - first_bid) * NTHREADS) {
        const f32x4 a = *(const f32x4*)(src + i * 8), b = *(const f32x4*)(src + i * 8 + 4);
        u32x4 w; w.x = cvtpk(a[0], a[1]); w.y = cvtpk(a[2], a[3]); w.z = cvtpk(b[0], b[1]); w.w = cvtpk(b[2], b[3]);
        *(u32x4*)(dst + i * 8) = w;
    }
}
__device__ __forceinline__ void p0_prologue(const Frame& F) {
    LAS float* scr = (LAS float*)(F.lds + F.wave * 16384);
    const int gw = (int)blockIdx.x * NWAVES + F.wave, NGW = (int)gridDim.x * NWAVES;
    int base = 0;
    for (int mi = 0; mi < NWMAT; ++mi) {
        const WDesc w = wdesc(F, mi);
        const int nit = (w.nslots / 32) * (w.K / 64);
        int first = (gw - (base % NGW) + NGW) % NGW;
        for (int it = first; it < nit; it += NGW) cvt_item(w, it, scr, F.lane);
        base += nit;
    }
    const float* x = F.a.in[I_X]; bf16_t* XB = (bf16_t*)(F.a.ws + WS_XB); float* SS = (float*)(F.a.ws + WS_SS);
    for (int row = gw; row < M_; row += NGW) {
        const f32x4* xr = (const f32x4*)(x + (size_t)row * D_) + F.lane;
        f32x4 v[4]; float s = 0.f;
#pragma unroll
        for (int j = 0; j < 4; ++j) { v[j] = xr[64 * j]; s += (v[j].x * v[j].x + v[j].y * v[j].y) + (v[j].z * v[j].z + v[j].w * v[j].w); }
        s = wave_sum(s);
        u32x2* o8 = (u32x2*)(XB + (size_t)row * D_) + F.lane;
#pragma unroll
        for (int j = 0; j < 4; ++j) { u32x2 w; w.x = cvtpk(v[j].x, v[j].y); w.y = cvtpk(v[j].z, v[j].w); o8[64 * j] = w; }
        if (F.lane < 16) SS[(size_t)row * 16 + F.lane] = (F.lane == 0) ? s : 0.f;
    }
    bf16_t* WH = (bf16_t*)(F.a.ws + WS_WDT); bf16_t* WL = WH + 32 * 1024;
    for (int i = (int)blockIdx.x * NTHREADS + F.tid; i < 1024 * 32; i += (int)gridDim.x * NTHREADS) { const int k = i >> 5, j = i & 31;
        const float v = F.a.in[I_WIN][(size_t)k * INP + 5120 + j] * F.a.in[I_NMIX][k];
        const unsigned hi = cvtpk(v, 0.f) & 0xffffu; const float r = v - __uint_as_float(hi << 16);
        WH[j * 1024 + k] = (bf16_t)hi; WL[j * 1024 + k] = (bf16_t)(cvtpk(r, 0.f) & 0xffffu); }
}

constexpr int CBT_TILE_ELEMS = 64 * 16;
__device__ __forceinline__ void p2_conv_dt(const Frame& F) {
    const bf16_t* BIG = (const bf16_t*)(F.a.ws + WS_BIG); bf16_t* BC = (bf16_t*)(F.a.ws + WS_AUX); bf16_t* CBT = (bf16_t*)F.a.out;
    const float* cw = F.a.in[I_CW]; const float* cb = F.a.in[I_CB];
    LAS unsigned char* L = F.lds;
    const int tid = F.tid, lane = F.lane, wave = F.wave, ql = lane & 31, hh = lane >> 5;
    for (int job = (int)blockIdx.x; job < NB_ * 32 * 4; job += (int)gridDim.x) {
        const int g = job & 3, c = (job >> 2) & 31, b = job >> 7;
        const size_t r0 = (size_t)b * T_ + (size_t)c * 128;
#pragma unroll 2
        for (int i = 0; i < 8; ++i) {
            const int idx = tid + 512 * i, row = idx >> 5, cc = idx & 31, isC = cc >> 4, ch = cc & 15;
            const int xcol = 2048 + isC * 512 + g * 128 + ch * 8, t = c * 128 + row;
            float a[8];
            { const f32x4 b0 = *(const f32x4*)(cb + xcol), b1 = *(const f32x4*)(cb + xcol + 4);
              a[0] = b0[0]; a[1] = b0[1]; a[2] = b0[2]; a[3] = b0[3]; a[4] = b1[0]; a[5] = b1[1]; a[6] = b1[2]; a[7] = b1[3]; }
#pragma unroll
            for (int k = 0; k < 4; ++k) {
                if (t - 3 + k >= 0) {
                    const u32x4 r = *(const u32x4*)(BIG + (r0 + row - 3 + k) * XBC + xcol);
                    const f32x4 w0 = *(const f32x4*)(cw + k * XBC + xcol), w1 = *(const f32x4*)(cw + k * XBC + xcol + 4);
                    a[0] += w0[0] * bflo(r.x); a[1] += w0[1] * bfhi(r.x); a[2] += w0[2] * bflo(r.y); a[3] += w0[3] * bfhi(r.y);
                    a[4] += w1[0] * bflo(r.z); a[5] += w1[1] * bfhi(r.z); a[6] += w1[2] * bflo(r.w); a[7] += w1[3] * bfhi(r.w);
                }
            }
#pragma unroll
            for (int j = 0; j < 8; ++j) a[j] = siluf_(a[j]);
            u32x4 w; w.x = cvtpk(a[0], a[1]); w.y = cvtpk(a[2], a[3]); w.z = cvtpk(a[4], a[5]); w.w = cvtpk(a[6], a[7]);
            *(LAS u32x4*)(L + isC * 32768 + off_b(row, ch)) = w;
        }
        __syncthreads();
#pragma unroll 1
        for (int ti = wave; ti < 10; ti += 8) {
            const int lt = (ti >= 6) ? 3 : (ti >= 3) ? 2 : (ti >= 1) ? 1 : 0, st = ti - lt * (lt + 1) / 2;
            f32x16_ S;
#pragma unroll
            for (int i = 0; i < 16; ++i) S[i] = 0.f;
#pragma unroll
            for (int ks = 0; ks < 8; ++ks) { const bf16x8 av = *(const LAS bf16x8*)(L + off_b(32 * st + ql, 2 * ks + hh)); const bf16x8 cv = *(const LAS bf16x8*)(L + 32768 + off_b(32 * lt + ql, 2 * ks + hh));
                S = __builtin_amdgcn_mfma_f32_32x32x16_bf16(av, cv, S, 0, 0, 0); }
            u32x4 w0, w1;
            w0.x = cvtpk(S[0], S[1]); w0.y = cvtpk(S[2], S[3]); w0.z = cvtpk(S[4], S[5]); w0.w = cvtpk(S[6], S[7]);
            w1.x = cvtpk(S[8], S[9]); w1.y = cvtpk(S[10], S[11]); w1.z = cvtpk(S[12], S[13]); w1.w = cvtpk(S[14], S[15]);
            bf16_t* dst = CBT + ((size_t)job * 10 + ti) * CBT_TILE_ELEMS + lane * 16;
            *(u32x4*)dst = w0; *(u32x4*)(dst + 8) = w1;
        }
        { const unsigned blk = (lane >> 4) & 1, q4 = (lane & 15) >> 2, p4 = lane & 3;
          bf16_t* fb = BC + (size_t)job * 32768 + lane * 8;
#pragma unroll
          for (int i = 0; i < 4; ++i) { const int f = wave + 8 * i, n8 = f >> 3, k8 = f & 7;
              const s16x4 t0 = __builtin_bit_cast(s16x4, __builtin_amdgcn_ds_read_tr16_b64_v4i16((LAS v4i16_t*)(L + off_b(16 * k8 + 8 * hh + q4, 4 * n8 + 2 * blk + (p4 >> 1)) + 8 * (p4 & 1))));
              const s16x4 t1 = __builtin_bit_cast(s16x4, __builtin_amdgcn_ds_read_tr16_b64_v4i16((LAS v4i16_t*)(L + off_b(16 * k8 + 8 * hh + 4 + q4, 4 * n8 + 2 * blk + (p4 >> 1)) + 8 * (p4 & 1))));
              const bf16x8 bfr = __builtin_shufflevector(t0, t1, 0, 1, 2, 3, 4, 5, 6, 7);
              *(bf16x8*)(fb + f * 512) = bfr;
              const u32x2 clo = *(const LAS u32x2*)(L + 32768 + off_b(32 * n8 + ql, 2 * k8) + 8 * hh), chi = *(const LAS u32x2*)(L + 32768 + off_b(32 * n8 + ql, 2 * k8 + 1) + 8 * hh);
              const u32x4 cfr = {clo.x, clo.y, chi.x, chi.y};
              *(u32x4*)(fb + 16384 + f * 512) = cfr; } }
        __syncthreads();
    }
    __syncthreads();
    const float* x = F.a.in[I_X]; const bf16_t* WH = (const bf16_t*)(F.a.ws + WS_WDT); const bf16_t* WL = WH + 32 * 1024; float* DT = (float*)(F.a.ws + WS_DT);
    const int kq = F.wave & 3, isub = F.wave >> 2;
    LAS float* part = (LAS float*)F.lds;
    for (int it2 = (int)blockIdx.x; it2 < M_ / 64; it2 += (int)gridDim.x) {
        const int item = it2 * 2 + isub;
        const float* xr = x + (size_t)(item * 32 + ql) * D_ + kq * 256 + 8 * hh;
        const bf16_t* whp = WH + ql * 1024 + kq * 256 + 8 * hh; const bf16_t* wlp = WL + ql * 1024 + kq * 256 + 8 * hh;
        f32x16_ acc;
#pragma unroll
        for (int i = 0; i < 16; ++i) acc[i] = 0.f;
        float ssq = 0.f;
#pragma unroll 8
        for (int ks = 0; ks < 16; ++ks) {
            const f32x4 a0 = *(const f32x4*)(xr + 16 * ks), a1 = *(const f32x4*)(xr + 16 * ks + 4);
            ssq += (a0[0] * a0[0] + a0[1] * a0[1]) + (a0[2] * a0[2] + a0[3] * a0[3]) + (a1[0] * a1[0] + a1[1] * a1[1]) + (a1[2] * a1[2] + a1[3] * a1[3]);
            u32x4 ah, al;
            ah.x = cvtpk(a0[0], a0[1]); ah.y = cvtpk(a0[2], a0[3]); ah.z = cvtpk(a1[0], a1[1]); ah.w = cvtpk(a1[2], a1[3]);
            al.x = cvtpk(a0[0] - bflo(ah.x), a0[1] - bfhi(ah.x)); al.y = cvtpk(a0[2] - bflo(ah.y), a0[3] - bfhi(ah.y));
            al.z = cvtpk(a1[0] - bflo(ah.z), a1[1] - bfhi(ah.z)); al.w = cvtpk(a1[2] - bflo(ah.w), a1[3] - bfhi(ah.w));
            const bf16x8 bh = *(const bf16x8*)(whp + 16 * ks), bl = *(const bf16x8*)(wlp + 16 * ks);
            acc = __builtin_amdgcn_mfma_f32_32x32x16_bf16(__builtin_bit_cast(bf16x8, ah), bh, acc, 0, 0, 0);
            acc = __builtin_amdgcn_mfma_f32_32x32x16_bf16(__builtin_bit_cast(bf16x8, ah), bl, acc, 0, 0, 0);
            acc = __builtin_amdgcn_mfma_f32_32x32x16_bf16(__builtin_bit_cast(bf16x8, al), bh, acc, 0, 0, 0);
        }
        LAS float* mine = part + ((isub * 4 + kq) * 17) * 64 + F.lane;
#pragma unroll
        for (int i = 0; i < 16; ++i) mine[i * 64] = acc[i];
        mine[16 * 64] = ssq;
        __syncthreads();
        if (kq == 0) {
            const LAS float* p0 = part + (isub * 4 * 17) * 64 + F.lane;
            float ss = 0.f;
#pragma unroll
            for (int q = 0; q < 4; ++q) ss += p0[(q * 17 + 16) * 64];
            ss += __shfl_xor(ss, 32);
            const float rstd = rsqrtf(ss * (1.f / 1024.f) + EPS), bias = F.a.in[I_DTB][ql];
#pragma unroll
            for (int r = 0; r < 16; ++r) { const int rr = (r & 3) + 8 * (r >> 2) + 4 * hh;
                const float a = (p0[r * 64] + p0[(17 + r) * 64]) + (p0[(34 + r) * 64] + p0[(51 + r) * 64]);
                const float v = a * __shfl(rstd, rr) + bias;
                DT[(size_t)(item * 32 + rr) * 32 + ql] = v > 20.f ? v : log1pf(__expf(v)); }
        }
        __syncthreads();
    }
}

constexpr int VP = 192;
__device__ __forceinline__ float xhalf_max(float m) { auto rr = __builtin_amdgcn_permlane32_swap(__float_as_uint(m), __float_as_uint(m), false, false); return fmaxf(__uint_as_float(rr[0]), __uint_as_float(rr[1])); }

__device__ __forceinline__ void att_scores(const bf16x8 (&kf)[4], const bf16x8 (&qf)[4], int ti, int ql, int hh, float slope2, float& mx, float& lsum, f32x16& o0, f32x16& o1, u32x4 (&pw)[2]) {
    const int dbase = 128 - 32 * ti + ql - 4 * hh;
    const float b0 = -slope2 * (float)dbase - mx;
    f32x16 sa;
#pragma unroll
    for (int i = 0; i < 16; ++i) sa[i] = b0;
#pragma unroll
    for (int s = 0; s < 4; ++s) sa = __builtin_amdgcn_mfma_f32_32x32x16_bf16(kf[s], qf[s], sa, 0, 0, 0);
#pragma unroll
    for (int i = 0; i < 16; ++i) sa[i] = fmaf(slope2, (float)((i & 3) + 8 * (i >> 2)), sa[i]);
    if (ti <= 0 || ti >= 4) {
#pragma unroll
        for (int i = 0; i < 16; ++i) { const int dist = dbase - ((i & 3) + 8 * (i >> 2)); if ((unsigned)dist > 128u) sa[i] = -3e30f; }
    }
    float rm = fmaxf(fmaxf(sa[0], sa[1]), fmaxf(sa[2], sa[3]));
#pragma unroll
    for (int i = 4; i < 16; i += 4) rm = fmaxf(rm, fmaxf(fmaxf(sa[i], sa[i + 1]), fmaxf(sa[i + 2], sa[i + 3])));
    rm = xhalf_max(rm);
    if (__any(rm > 6.f)) {
        const float sh = (rm > 6.f) ? rm : 0.f, alpha = fast_exp2(-sh);
        mx += sh; lsum *= alpha;
#pragma unroll
        for (int i = 0; i < 16; ++i) { sa[i] -= sh; o0[i] *= alpha; o1[i] *= alpha; }
    }
    float ps = 0.f;
#pragma unroll
    for (int i = 0; i < 16; ++i) { const float pv = fast_exp2(sa[i]); sa[i] = pv; ps += pv; }
    lsum += ps;
#pragma unroll
    for (int s = 0; s < 2; ++s) { pw[s].x = cvtpk(sa[8 * s], sa[8 * s + 1]); pw[s].y = cvtpk(sa[8 * s + 2], sa[8 * s + 3]); pw[s].z = cvtpk(sa[8 * s + 4], sa[8 * s + 5]); pw[s].w = cvtpk(sa[8 * s + 6], sa[8 * s + 7]); }
}
template <int G_> __device__ __forceinline__ void att_mfma2(const Frame& F, const QKVSet qs) {
    constexpr int d = (G_ == 0) ? 1 : (G_ == 1) ? 4 : 16, lu = T_ / d, ntile = lu / 64, nitems = NB_ * 16 * d * ntile;
    const bf16_t* Qb = qs.q; const bf16_t* Kb = qs.k; const bf16_t* Vb = qs.v; bf16_t* OUT = (bf16_t*)(F.a.ws + WS_AUX); float* LSE = (float*)(F.a.ws + WS_LSE);
    const int lane = F.lane, ql = lane & 31, hh = lane >> 5;
    LAS unsigned char* Vs = F.lds + F.wave * 20480;
    LAS float* Os = (LAS float*)(Vs + 6144); LAS float* wtab = (LAS float*)(Vs + 6144 + 32 * 272);
    const int gw = (int)blockIdx.x * NWAVES + F.wave, NGW = (int)gridDim.x * NWAVES;
    const int trb = (4 * hh + ((lane & 15) >> 2)) * VP + (16 * ((lane >> 4) & 1) + 4 * (lane & 3)) * 2;
    for (int item = gw; item < nitems; item += NGW) {
        const int ut = item % ntile; int rest = item / ntile; const int r = rest % d; rest /= d; const int h = rest & 15, b = rest >> 4;
        const int u0 = ut * 64;
        const size_t rowqA = (size_t)b * T_ + (size_t)(u0 + ql) * d + r, rowqB = rowqA + (size_t)32 * d;
        bf16x8 qA[4], qB[4];
#pragma unroll
        for (int s = 0; s < 4; ++s) { qA[s] = *(const bf16x8*)(Qb + rowqA * D_ + h * 64 + 16 * s + 8 * hh); qB[s] = *(const bf16x8*)(Qb + rowqB * D_ + h * 64 + 16 * s + 8 * hh); }
        const float slope2 = fast_exp2(-0.5f * (float)(h + 1)) * (float)d * LOG2E;
        float mxA = 0.f, lsA = 0.f, mxB = 0.f, lsB = 0.f;
        f32x16 oA0, oA1, oB0, oB1;
#pragma unroll
        for (int i = 0; i < 16; ++i) { oA0[i] = 0.f; oA1[i] = 0.f; oB0[i] = 0.f; oB1[i] = 0.f; }
#define ATT_LOAD(TI, KF, VV) do { const int ub_ = u0 - 128 + 32 * (TI); const size_t rowk_ = (size_t)b * T_ + (size_t)(ub_ + ql) * d + r; \
            _Pragma("unroll") for (int s = 0; s < 4; ++s) KF[s] = *(const bf16x8*)(Kb + rowk_ * D_ + h * 64 + 16 * s + 8 * hh); \
            _Pragma("unroll") for (int j = 0; j < 4; ++j) { const size_t rowv_ = (size_t)b * T_ + (size_t)(ub_ + 8 * j + (lane >> 3)) * d + r; VV[j] = *(const u32x4*)(Vb + rowv_ * D_ + h * 64 + (lane & 7) * 8); } } while (0)
#define ATT_TILE2(KF, VV, TI) do { const int i_ = (TI); u32x4 pwA[2], pwB[2]; \
            att_scores(KF, qA, i_, ql, hh, slope2, mxA, lsA, oA0, oA1, pwA); att_scores(KF, qB, i_ - 1, ql, hh, slope2, mxB, lsB, oB0, oB1, pwB); \
            _Pragma("unroll") for (int j = 0; j < 4; ++j) *(LAS u32x4*)(Vs + (8 * j + (lane >> 3)) * VP + (lane & 7) * 16) = VV[j]; \
            _Pragma("unroll") for (int dt = 0; dt < 2; ++dt) _Pragma("unroll") for (int s = 0; s < 2; ++s) { \
                const s16x4 lo = __builtin_bit_cast(s16x4, __builtin_amdgcn_ds_read_tr16_b64_v4i16((LAS v4i16_t*)(Vs + trb + (16 * s) * VP + dt * 64))); \
                const s16x4 hi = __builtin_bit_cast(s16x4, __builtin_amdgcn_ds_read_tr16_b64_v4i16((LAS v4i16_t*)(Vs + trb + (16 * s + 8) * VP + dt * 64))); \
                const bf16x8 vf = __builtin_shufflevector(lo, hi, 0, 1, 2, 3, 4, 5, 6, 7); \
                { if (dt == 0) oA0 = __builtin_amdgcn_mfma_f32_32x32x16_bf16(vf, __builtin_bit_cast(bf16x8, pwA[s]), oA0, 0, 0, 0); else oA1 = __builtin_amdgcn_mfma_f32_32x32x16_bf16(vf, __builtin_bit_cast(bf16x8, pwA[s]), oA1, 0, 0, 0); } \
                { if (dt == 0) oB0 = __builtin_amdgcn_mfma_f32_32x32x16_bf16(vf, __builtin_bit_cast(bf16x8, pwB[s]), oB0, 0, 0, 0); else oB1 = __builtin_amdgcn_mfma_f32_32x32x16_bf16(vf, __builtin_bit_cast(bf16x8, pwB[s]), oB1, 0, 0, 0); } } } while (0)
        const int i0 = (ut >= 2) ? 0 : 4 - 2 * ut;
        bf16x8 k0[4]; u32x4 v0[4];
#pragma unroll 1
        for (int i = i0; i < 6; ++i) {
            ATT_LOAD(i, k0, v0);
            ATT_TILE2(k0, v0, i);
        }
#undef ATT_LOAD
#undef ATT_TILE2
#define ATT_EPI(O0, O1, MX, LS, ROWQ, UQ) do { \
        const float l = LS + __shfl_xor(LS, 32); \
        float wprev = 0.f, wcur, lse_new; \
        if (G_ == 2) { wcur = fast_rcp(l); lse_new = MX + __log2f(l); } \
        else { const float lp = LSE[ROWQ * 16 + h], M2 = fmaxf(lp, MX); const float wp = fast_exp2(lp - M2), wc = fast_exp2(MX - M2), den = wp + wc * l, rden = fast_rcp(den); \
            wprev = wp * rden; wcur = wc * rden; lse_new = M2 + __log2f(den); } \
        _Pragma("unroll") for (int dt = 0; dt < 2; ++dt) _Pragma("unroll") for (int c = 0; c < 4; ++c) { f32x4 v; \
            if (dt == 0) { v[0] = O0[4 * c] * wcur; v[1] = O0[4 * c + 1] * wcur; v[2] = O0[4 * c + 2] * wcur; v[3] = O0[4 * c + 3] * wcur; } \
            else { v[0] = O1[4 * c] * wcur; v[1] = O1[4 * c + 1] * wcur; v[2] = O1[4 * c + 2] * wcur; v[3] = O1[4 * c + 3] * wcur; } \
            *(LAS f32x4*)(Os + ql * 68 + 32 * dt + 8 * c + 4 * hh) = v; } \
        if (hh == 0) wtab[ql] = wprev; \
        _Pragma("unroll") for (int j = 0; j < 4; ++j) { const int qi = 8 * j + (lane >> 3), ch = lane & 7; \
            const f32x4 a = *(const LAS f32x4*)(Os + qi * 68 + ch * 8), c4 = *(const LAS f32x4*)(Os + qi * 68 + ch * 8 + 4); \
            u32x4* pp = (u32x4*)(OUT + ((size_t)b * T_ + (size_t)((UQ) + qi) * d + r) * D_ + h * 64 + ch * 8); \
            float r8[8] = {a[0], a[1], a[2], a[3], c4[0], c4[1], c4[2], c4[3]}; \
            if (G_ != 2) { const float wp = wtab[qi]; const u32x4 pv = *pp; \
                r8[0] += wp * bflo(pv.x); r8[1] += wp * bfhi(pv.x); r8[2] += wp * bflo(pv.y); r8[3] += wp * bfhi(pv.y); r8[4] += wp * bflo(pv.z); r8[5] += wp * bfhi(pv.z); r8[6] += wp * bflo(pv.w); r8[7] += wp * bfhi(pv.w); } \
            u32x4 w; w.x = cvtpk(r8[0], r8[1]); w.y = cvtpk(r8[2], r8[3]); w.z = cvtpk(r8[4], r8[5]); w.w = cvtpk(r8[6], r8[7]); \
            *pp = w; } \
        if (hh == 0) LSE[ROWQ * 16 + h] = lse_new; } while (0)
        ATT_EPI(oA0, oA1, mxA, lsA, rowqA, u0);
        ATT_EPI(oB0, oB1, mxB, lsB, rowqB, u0 + 32);
#undef ATT_EPI
    }
}

template <int YPITCH> __device__ __forceinline__ void p3_ssd_v4(const Frame& F, bf16_t* YO) {
    constexpr int ypitch = YPITCH;
    constexpr int O_IMG = 0, IMG_SET = 24576, O_ARR = 49152, ARR_SET = 1600, O_ST = 52352, ST_SET = 8192, O_ACS = 68736, O_TOT = 85120, O_YP = 85248, O_YA = 89344, O_XR = 89360, XR_W = 2240, O_HALO = 98320, O_YT = 98816;
#define SSD_BAR() do { asm volatile("s_waitcnt lgkmcnt(0)" ::: "memory"); __builtin_amdgcn_s_barrier(); asm volatile("" ::: "memory"); } while (0)
    LAS unsigned char* L = F.lds;
    bf16_t* BIG = (bf16_t*)(F.a.ws + WS_BIG); const bf16_t* BC = (const bf16_t*)(F.a.ws + WS_AUX); const float* DT = (const float*)(F.a.ws + WS_DT);
    const bf16_t* CBT = (const bf16_t*)F.a.out;
    LAS float* acs_all = (LAS float*)(F.lds + O_ACS); LAS float* tot_all = (LAS float*)(F.lds + O_TOT);
    const int tid = F.tid, lane = F.lane, wave = F.wave, ql = lane & 31, hh = lane >> 5;
    LAS float* YoffP = (LAS float*)(L + O_YP); LAS unsigned* yflag = (LAS unsigned*)(L + O_YA);
    for (int u0_ = blockIdx.x; u0_ < 256; u0_ += gridDim.x) {
        const int u = (gridDim.x == 256) ? (((u0_ & 7) + 8 * (u0_ >> 7)) * 16 + ((u0_ >> 3) & 15)) : u0_;
        const int b = u >> 6, h = (u >> 1) & 31, ph = u & 1, g = h >> 3, ch0 = h * 64 + ph * 32;
        const float A_h = -__expf(F.a.in[I_ALOG][h]), D_h = F.a.in[I_DSKIP][h];
        float cwv[4];
#pragma unroll
        for (int k = 0; k < 4; ++k) cwv[k] = F.a.in[I_CW][k * XBC + ch0 + ql];
        const float cbv = F.a.in[I_CB][ch0 + ql];
        f32x16 st;
#pragma unroll
        for (int i = 0; i < 16; ++i) st[i] = 0.f;
        u32x4 fr[8];
        const int ftile = (wave >= 4) ? (wave - 4) : (wave == 0) ? 3 : (wave == 1) ? 0 : (wave == 2) ? 2 : 1;
#define SSD_FLOAD(cc) do { const bf16_t* fp_ = BC + ((size_t)(b * 32 + (cc)) * 4 + g) * 32768 + ((wave >= 4) ? 0 : 16384) + (size_t)ftile * 8 * 512 + lane * 8; \
            _Pragma("unroll") for (int k = 0; k < 8; ++k) fr[k] = *(const u32x4*)(fp_ + k * 512); } while (0)
        u32x4 sx[6]; float dta = 0.f, dtb = 0.f;
        const int wq = wave - 4;
#define SSD_XLOAD(cc) do { const size_t r0_ = (size_t)b * T_ + (size_t)(cc) * 128; \
            _Pragma("unroll") for (int i = 0; i < 3; ++i) { const int j = 16 * i + (lane >> 2); const long grow = (long)r0_ + 32 * wq - 3 + j; \
                const bool inb = (j < 35) && !(wq == 0 && j < 3); sx[i] = inb ? *(const u32x4*)(BIG + grow * XBC + ch0 + (lane & 3) * 8) : (u32x4){0u, 0u, 0u, 0u}; } \
            dta = DT[(r0_ + 2 * lane) * 32 + h]; dtb = DT[(r0_ + 2 * lane + 1) * 32 + h]; } while (0)
        const int lt0 = (wave < 2) ? 3 : (wave == 2) ? 2 : 1, s_lo0 = (wave == 1) ? 2 : 0, s_hi0 = (wave == 0) ? 1 : (wave == 1) ? 3 : (wave == 2) ? 2 : 1;
#define SSD_SLOAD(cc) do { const bf16_t* jb_ = CBT + ((size_t)(b * 32 + (cc)) * 4 + g) * 10 * CBT_TILE_ELEMS + lane * 16; \
            _Pragma("unroll") for (int k = 0; k < 3; ++k) if (s_lo0 + k <= s_hi0) { const bf16_t* sp = jb_ + (size_t)(lt0 * (lt0 + 1) / 2 + s_lo0 + k) * CBT_TILE_ELEMS; sx[2 * k] = *(const u32x4*)sp; sx[2 * k + 1] = *(const u32x4*)(sp + 8); } \
            if (wave == 1) { sx[4] = *(const u32x4*)jb_; sx[5] = *(const u32x4*)(jb_ + 8); } } while (0)
#define SSD_PREP(cc) do { const int sn_ = (cc) & 1; LAS unsigned char* xrw = L + O_XR + wq * XR_W; \
            LAS float* dts_ = (LAS float*)(L + O_ARR + sn_ * ARR_SET); LAS float* ea_ = dts_ + 128; LAS float* wd_ = dts_ + 256; \
              \
            _Pragma("unroll") for (int i = 0; i < 3; ++i) { const int j = 16 * i + (lane >> 2); \
                u32x4 v = sx[i]; if (wq == 0 && j < 3) v = *(const LAS u32x4*)(L + O_HALO + sn_ * 192 + j * 64 + (lane & 3) * 16); \
                if (j < 35) *(LAS u32x4*)(xrw + j * 64 + (lane & 3) * 16) = v; \
                if (wq == 3 && j >= 32 && j < 35) *(LAS u32x4*)(L + O_HALO + (sn_ ^ 1) * 192 + (j - 32) * 64 + (lane & 3) * 16) = v; } \
              \
            { const float e0 = acs_all[(cc) * 128 + 2 * lane], e1 = acs_all[(cc) * 128 + 2 * lane + 1], tot = tot_all[(cc)]; \
              dts_[2 * lane] = dta; dts_[2 * lane + 1] = dtb; ea_[2 * lane] = __expf(e0); ea_[2 * lane + 1] = __expf(e1); \
              wd_[2 * lane] = __expf(tot - e0); wd_[2 * lane + 1] = __expf(tot - e1); if (lane == 0) dts_[384] = __expf(tot); } \
              \
            { _Pragma("unroll 1") for (int k2 = 0; k2 < 2; ++k2) { float xr_[11]; float xcv[8], xsv[8], xwv[8]; \
                  _Pragma("unroll") for (int i = 0; i < 11; ++i) xr_[i] = __uint_as_float((unsigned)*(const LAS bf16_t*)(xrw + (16 * hh + 8 * k2 + i) * 64 + ql * 2) << 16); \
                  _Pragma("unroll") for (int j = 0; j < 8; ++j) { const int jj = 8 * k2 + j; float v = cbv; \
                      _Pragma("unroll") for (int k = 0; k < 4; ++k) v += cwv[k] * xr_[j + k]; \
                      const int l_ = 32 * wq + 16 * hh + jj; xcv[j] = siluf_(v); xsv[j] = xcv[j] * dts_[l_]; xwv[j] = xsv[j] * wd_[l_]; } \
                  u32x4 w0, w1, w2; \
                  w0.x = cvtpk(xcv[0], xcv[1]); w0.y = cvtpk(xcv[2], xcv[3]); w0.z = cvtpk(xcv[4], xcv[5]); w0.w = cvtpk(xcv[6], xcv[7]); \
                  w1.x = cvtpk(xsv[0], xsv[1]); w1.y = cvtpk(xsv[2], xsv[3]); w1.z = cvtpk(xsv[4], xsv[5]); w1.w = cvtpk(xsv[6], xsv[7]); \
                  w2.x = cvtpk(xwv[0], xwv[1]); w2.y = cvtpk(xwv[2], xwv[3]); w2.z = cvtpk(xwv[4], xwv[5]); w2.w = cvtpk(xwv[6], xwv[7]); \
                  const unsigned o = off_b(ql, 4 * wq + 2 * hh + k2); LAS unsigned char* img = L + O_IMG + sn_ * IMG_SET; \
                  *(LAS u32x4*)(img + o) = w1; *(LAS u32x4*)(img + 8192 + o) = w2; *(LAS u32x4*)(img + 16384 + o) = w0; } } } while (0)
        { float da[4], db[4];
#pragma unroll
          for (int k = 0; k < 4; ++k) { const size_t r0_ = (size_t)b * T_ + (size_t)(wave + 8 * k) * 128; da[k] = DT[(r0_ + 2 * lane) * 32 + h]; db[k] = DT[(r0_ + 2 * lane + 1) * 32 + h]; }
#pragma unroll
          for (int k = 0; k < 4; ++k) { const int cc = wave + 8 * k; const float a0 = da[k] * A_h, a1 = db[k] * A_h; float v = a0 + a1;
#pragma unroll
              for (int off = 1; off < 64; off <<= 1) { const float t = __shfl_up(v, off); if (lane >= off) v += t; }
              acs_all[cc * 128 + 2 * lane] = v - a1; acs_all[cc * 128 + 2 * lane + 1] = v; if (lane == 63) tot_all[cc] = v; } }
        if (tid < 48) *(LAS unsigned*)(L + O_HALO + tid * 4) = 0u;
        if (tid == 0) *yflag = 0u;
        SSD_BAR();
        if (wave >= 4) {
#pragma unroll
            for (int s2 = 0; s2 < 2; ++s2) *(LAS u32x4*)(L + O_ST + ((wave - 4) * 2 + s2) * 1024 + lane * 16) = (u32x4){0u, 0u, 0u, 0u};
            SSD_XLOAD(0); SSD_PREP(0); SSD_XLOAD(1);
        } else SSD_SLOAD(0);
        SSD_FLOAD(0);
        SSD_BAR();
        for (int c = 0; c < T_ / 128; ++c) {
            int lane_o = F.lane; asm volatile("" : "+v"(lane_o)); const int lane = lane_o, ql = lane & 31, hh = lane >> 5;
            const int sc = c & 1;
            const size_t row0 = (size_t)b * T_ + (size_t)c * 128;
            LAS unsigned char* img = L + O_IMG + sc * IMG_SET;
            LAS float* dts = (LAS float*)(L + O_ARR + sc * ARR_SET); LAS float* ea = dts + 128; LAS float* acs = acs_all + c * 128;
            if (wave < 4) {
#pragma unroll 1
                for (int pass = 0; pass < 2; ++pass) {
                    if (pass == 1 && wave != 1) break;
                    const int lt = (pass == 1) ? 0 : (wave < 2) ? 3 : (wave == 2) ? 2 : 1;
                    const int s_lo = (pass == 0 && wave == 1) ? 2 : 0;
                    const int s_hi = (pass == 1) ? 0 : (wave == 0) ? 1 : (wave == 1) ? 3 : (wave == 2) ? 2 : 1;
                    f32x16 y;
#pragma unroll
                    for (int i = 0; i < 16; ++i) y[i] = 0.f;
                    if (!(wave == 1 && pass == 0)) {
#pragma unroll
                        for (int kg = 0; kg < 8; ++kg) {
                            const bf16x8 bfv = *(const LAS bf16x8*)(L + O_ST + sc * ST_SET + kg * 1024 + lane * 16);
                            y = __builtin_amdgcn_mfma_f32_32x32x16_bf16(__builtin_bit_cast(bf16x8, fr[kg]), bfv, y, 0, 0, 0);
                            if (kg == 3) __builtin_amdgcn_sched_barrier(0);
                        }
#pragma unroll
                        for (int c4 = 0; c4 < 4; ++c4) { const f32x4 e = *(const LAS f32x4*)(ea + 32 * lt + 8 * c4 + 4 * hh);
                            const u32x2 xv = *(const LAS u32x2*)(img + 16384 + off_b(ql, 4 * lt + c4) + 8 * hh);
                            y[4 * c4] = y[4 * c4] * e[0] + D_h * bflo(xv.x); y[4 * c4 + 1] = y[4 * c4 + 1] * e[1] + D_h * bfhi(xv.x);
                            y[4 * c4 + 2] = y[4 * c4 + 2] * e[2] + D_h * bflo(xv.y); y[4 * c4 + 3] = y[4 * c4 + 3] * e[3] + D_h * bfhi(xv.y); }
                    }
                    const float acs_l = acs[32 * lt + ql];
#pragma unroll
                    for (int k = 0; k < 3; ++k) {
                        const int stl = s_lo + k;
                        if (stl > s_hi) break;
                        const u32x4 w0 = (pass == 1) ? sx[4] : sx[2 * k], w1 = (pass == 1) ? sx[5] : sx[2 * k + 1];
                        f32x16 S;
                        S[0] = bflo(w0.x); S[1] = bfhi(w0.x); S[2] = bflo(w0.y); S[3] = bfhi(w0.y); S[4] = bflo(w0.z); S[5] = bfhi(w0.z); S[6] = bflo(w0.w); S[7] = bfhi(w0.w);
                        S[8] = bflo(w1.x); S[9] = bfhi(w1.x); S[10] = bflo(w1.y); S[11] = bfhi(w1.y); S[12] = bflo(w1.z); S[13] = bfhi(w1.z); S[14] = bflo(w1.w); S[15] = bfhi(w1.w);
#pragma unroll
                        for (int c4 = 0; c4 < 4; ++c4) { const f32x4 as = *(const LAS f32x4*)(acs + 32 * stl + 8 * c4 + 4 * hh);
#pragma unroll
                            for (int j = 0; j < 4; ++j) { const int sidx = 8 * c4 + 4 * hh + j; const bool ok = (stl < lt) || (sidx <= ql);
                                S[4 * c4 + j] = ok ? S[4 * c4 + j] * __expf(acs_l - as[j]) : 0.f; } }
#pragma unroll
                        for (int s2 = 0; s2 < 2; ++s2) {
                            u32x4 wf; wf.x = cvtpk(S[8 * s2], S[8 * s2 + 1]); wf.y = cvtpk(S[8 * s2 + 2], S[8 * s2 + 3]); wf.z = cvtpk(S[8 * s2 + 4], S[8 * s2 + 5]); wf.w = cvtpk(S[8 * s2 + 6], S[8 * s2 + 7]);
                            const int kg = 2 * stl + s2;
                            const u32x2 xlo = *(const LAS u32x2*)(img + off_b(ql, 2 * kg) + 8 * hh), xhi = *(const LAS u32x2*)(img + off_b(ql, 2 * kg + 1) + 8 * hh);
                            const u32x4 xb = {xlo.x, xlo.y, xhi.x, xhi.y};
                            y = __builtin_amdgcn_mfma_f32_32x32x16_bf16(__builtin_bit_cast(bf16x8, wf), __builtin_bit_cast(bf16x8, xb), y, 0, 0, 0);
                        }
                    }
                    if (wave == 1 && pass == 0) {
#pragma unroll
                        for (int r = 0; r < 16; ++r) YoffP[((r & 3) + 8 * (r >> 2) + 4 * hh) * 32 + ql] = y[r];
                        if (lane == 0) __hip_atomic_store(yflag, (unsigned)(c + 1), __ATOMIC_RELAXED, __HIP_MEMORY_SCOPE_WORKGROUP);
                    } else {
                        if (wave == 0) {
                            unsigned spins = 0;
                            while (__hip_atomic_load(yflag, __ATOMIC_RELAXED, __HIP_MEMORY_SCOPE_WORKGROUP) != (unsigned)(c + 1) && ++spins < (1u << 22)) __builtin_amdgcn_s_sleep(1);
                            asm volatile("" ::: "memory");
#pragma unroll
                            for (int r = 0; r < 16; ++r) y[r] += YoffP[((r & 3) + 8 * (r >> 2) + 4 * hh) * 32 + ql];
                        }
                        {
                            LAS unsigned char* yt = L + O_YT + wave * 2048;
#pragma unroll
                            for (int r = 0; r < 16; ++r) *(LAS bf16_t*)(yt + ((r & 3) + 8 * (r >> 2) + 4 * hh) * 64 + ql * 2) = (bf16_t)(cvtpk(y[r], 0.f) & 0xffffu);
#pragma unroll
                            for (int k2 = 0; k2 < 2; ++k2) { const int kk = lane + 64 * k2, li = kk >> 2, c4 = kk & 3;
                                const u32x4 w = *(const LAS u32x4*)(yt + li * 64 + c4 * 16);
                                *(u32x4*)(YO + (row0 + 32 * lt + li) * ypitch + ch0 + c4 * 8) = w; }
                        }
                    }
                }
                SSD_SLOAD(c + 1 < T_ / 128 ? c + 1 : c); SSD_FLOAD(c + 1 < T_ / 128 ? c + 1 : c);
            } else {
                const int nt = wave - 4, lt = nt;
                {
                const float cd = dts[384];
#pragma unroll
                for (int i = 0; i < 16; ++i) st[i] *= cd;
#pragma unroll
                for (int ks = 0; ks < 8; ++ks) {
                    const bf16x8 bfv = *(const LAS bf16x8*)(img + 8192 + off_b(ql, 2 * ks + hh));
                    st = __builtin_amdgcn_mfma_f32_32x32x16_bf16(__builtin_bit_cast(bf16x8, fr[ks]), bfv, st, 0, 0, 0);
                    if (ks == 3) __builtin_amdgcn_sched_barrier(0);
                }
                }
#pragma unroll
                for (int s2 = 0; s2 < 2; ++s2) { u32x4 w; w.x = cvtpk(st[8 * s2], st[8 * s2 + 1]); w.y = cvtpk(st[8 * s2 + 2], st[8 * s2 + 3]); w.z = cvtpk(st[8 * s2 + 4], st[8 * s2 + 5]); w.w = cvtpk(st[8 * s2 + 6], st[8 * s2 + 7]);
                    *(LAS u32x4*)(L + O_ST + (sc ^ 1) * ST_SET + ((wave - 4) * 2 + s2) * 1024 + lane * 16) = w; }
                SSD_FLOAD(c + 1 < T_ / 128 ? c + 1 : c);
                if (c + 1 < T_ / 128) { SSD_PREP(c + 1); SSD_XLOAD(c + 2 < T_ / 128 ? c + 2 : c + 1); }
            }
            SSD_BAR();
        }
#undef SSD_FLOAD
#undef SSD_XLOAD
#undef SSD_SLOAD
#undef SSD_PREP
        SSD_BAR();
    }
}

enum { E_STORE = 0, E_Z, E_RES, E_GATE, E_GU, E_QKV, E_FINAL, E_RESSEG };
struct GOp { const bf16_t* A; const bf16_t* Bt; int lda, N, K, epi; bf16_t* ob; bf16_t* ob2; bf16_t* ob3; int ldc; const float* SS; float* SSo; const bf16_t* xin; bf16_t* xo; const bf16_t* ple; };

__device__ __forceinline__ void run_gemm(const Frame& F, const GOp& op) {
    pg8::Gemm g{op.A, op.Bt, M_, op.N, op.K, op.lda};
    pg8::StaticOrder S; S.init(M_, op.N, (int)gridDim.x, (int)blockIdx.x);
    LAS float* tab = (LAS float*)(F.lds + RING_BYTES + 1024);
    switch (op.epi) {
    case E_STORE: { pg8::EpiStore E{op.ob, op.ldc, op.SS, tab}; pg8::gemm_phase(F.lds, F.tid, g, S, E); } break;
    case E_Z: { pg8::EpiZ E{op.ob, op.SS, (float*)(F.a.ws + WS_GN), tab}; pg8::gemm_phase(F.lds, F.tid, g, S, E); } break;
    case E_RES: { pg8::EpiRes<false, false> E{nullptr, op.xin, op.xo, op.SSo, nullptr, nullptr, nullptr}; pg8::gemm_phase(F.lds, F.tid, g, S, E); } break;
    case E_RESSEG: { pg8::EpiRes<false, false, true> E{nullptr, op.xin, op.xo, op.SSo, nullptr, (const float*)(F.a.ws + WS_GN), (LAS float*)(F.lds + RING_BYTES + 2048)}; pg8::gemm_phase(F.lds, F.tid, g, S, E); } break;
    case E_GATE: { pg8::EpiRes<true, false> E{nullptr, op.xin, op.xo, op.SSo, op.ple, nullptr, nullptr}; pg8::gemm_phase(F.lds, F.tid, g, S, E); } break;
    case E_FINAL: { pg8::EpiRes<true, true> E{F.a.out, op.xin, nullptr, nullptr, op.ple, nullptr, nullptr}; pg8::gemm_phase(F.lds, F.tid, g, S, E); } break;
    case E_GU: { pg8::EpiGU E{op.ob, op.SS, tab}; pg8::gemm_phase(F.lds, F.tid, g, S, E); } break;
    case E_QKV: { pg8::EpiQKV E{op.ob, (long)(op.ob2 - op.ob), (long)(op.ob3 - op.ob), op.SS, F.a.in[I_QN], F.a.in[I_KN], tab}; pg8::gemm_phase(F.lds, F.tid, g, S, E); } break;
    default: break;
    }
}

constexpr int NPHASE = 20;
__device__ __forceinline__ bool phase_gemm(const Frame& F, int ph, int i, GOp& g0) {
    unsigned char* ws = F.a.ws;
    bf16_t* XB = (bf16_t*)(ws + WS_XB); bf16_t* BIG = (bf16_t*)(ws + WS_BIG); bf16_t* AUX = (bf16_t*)(ws + WS_AUX); bf16_t* PB = (bf16_t*)(ws + WS_PB);
    float* SS = (float*)(ws + WS_SS);
    bf16_t* X2 = (bf16_t*)F.a.out;
    GOp z{}; g0 = z;
    auto W = [&](size_t off) { return (const bf16_t*)(ws + off); };
    if (i == 1) {
        if (ph != 8 && ph != 17) return false;
        g0.A = (ph == 8) ? PB : PB + (size_t)M_ * PLED; g0.lda = 256; g0.Bt = W(ph == 8 ? W_PP0 : W_PP1); g0.N = 1024; g0.K = 256; g0.epi = E_STORE; g0.ob = AUX; g0.ldc = 1024; g0.SS = nullptr; return true;
    }
    switch (ph) {
    case 1: g0.A = XB; g0.lda = 1024; g0.Bt = W(W_XBC); g0.N = 3072; g0.K = 1024; g0.epi = E_STORE; g0.ob = BIG; g0.ldc = XBC; g0.SS = SS; return true;
    case 4: g0.A = XB; g0.lda = 1024; g0.Bt = W(W_Z); g0.N = 2048; g0.K = 1024; g0.epi = E_Z; g0.ob = BIG; g0.SS = SS; return true;
    case 6: g0.A = BIG; g0.lda = XBC; g0.Bt = W(W_OUT); g0.N = 1024; g0.K = 2048; g0.epi = E_RESSEG; g0.xin = XB; g0.xo = XB; g0.SSo = SS; return true;
    case 7: g0.A = XB; g0.lda = 1024; g0.Bt = W(W_GU0); g0.N = 5632; g0.K = 1024; g0.epi = E_GU; g0.ob = BIG; g0.SS = SS; return true;
    case 8: g0.A = BIG; g0.lda = FF; g0.Bt = W(W_D0); g0.N = 1024; g0.K = FF; g0.epi = E_RES; g0.xin = XB; g0.xo = XB; g0.SSo = nullptr; return true;
    case 9: g0.A = XB; g0.lda = 1024; g0.Bt = W(W_PG0); g0.N = 1024; g0.K = 1024; g0.epi = E_GATE; g0.xin = XB; g0.xo = X2; g0.SSo = SS; g0.ple = AUX; return true;
    case 10: case 11: case 13: { const int g = (ph <= 11) ? 12 - ph : 0;   const QKVSet qs = qkv_set(ws, F.a.out, ph == 11 ? 1 : 0);
            g0.A = X2; g0.lda = 1024; g0.Bt = W(W_QKV) + (size_t)g * QG * 1024; g0.N = QG; g0.K = 1024; g0.epi = E_QKV; g0.ob = qs.q; g0.ob2 = qs.k; g0.ob3 = qs.v; g0.SS = SS; return true; }
    case 16: g0.A = AUX; g0.lda = 1024; g0.Bt = W(W_O); g0.N = 1024; g0.K = 1024; g0.epi = E_RES; g0.xin = X2; g0.xo = XB; g0.SSo = SS; return true;
    case 17: g0.A = XB; g0.lda = 1024; g0.Bt = W(W_GU1); g0.N = 5632; g0.K = 1024; g0.epi = E_GU; g0.ob = BIG; g0.SS = SS; return true;
    case 18: g0.A = BIG; g0.lda = FF; g0.Bt = W(W_D1); g0.N = 1024; g0.K = FF; g0.epi = E_RES; g0.xin = XB; g0.xo = XB; g0.SSo = nullptr; return true;
    case 19: g0.A = XB; g0.lda = 1024; g0.Bt = W(W_PG1); g0.N = 1024; g0.K = 1024; g0.epi = E_FINAL; g0.xin = XB; g0.ple = AUX; return true;
    default: return false;
    }
}

__global__ void __launch_bounds__(NTHREADS, 2) mk_fwd(Args args) {
    extern __shared__ __attribute__((aligned(16))) unsigned char lds_raw[];
    Frame F(args);
    F.lds = (LAS unsigned char*)lds_raw;
    F.tid = threadIdx.x; F.lane = F.tid & 63; F.wave = __builtin_amdgcn_readfirstlane(F.tid >> 6);
    for (int u = F.tid; u < (LDS_BYTES - LDSCTL_OFF) / 4; u += NTHREADS) ((LAS unsigned*)(F.lds + LDSCTL_OFF))[u] = 0u;
    __syncthreads();
    const int lo = args.ph_lo, hi = args.ph_hi;
    XcdBarrier bar; bar.bar = (unsigned*)(F.a.ws + WS_CTL) + 4096; bar.x = 0; bar.st = nullptr;
    unsigned bar_epoch = 0u;
    if (hi - lo > 1) bar = xcd_barrier_post((unsigned*)(F.a.ws + WS_CTL) + 4096, (volatile LAS unsigned*)(F.lds + MISC_OFF) + 8);

    for (int ph0 = lo; ph0 < hi + DUP_N; ++ph0) {
        int ph = ph0; if (DUP_N > 0) { if (DUP_PHASE >= NPHASE) { if (ph0 >= NPHASE) ph = 99; } else if (ph0 > DUP_PHASE + DUP_N) ph = ph0 - DUP_N; else if (ph0 > DUP_PHASE) ph = DUP_PHASE; }
        if (ph == 5 || ph == 12 || ph == 14) continue;
        { int t_ = threadIdx.x; asm volatile("" : "+v"(t_)); F.tid = t_; F.lane = t_ & 63; F.wave = __builtin_amdgcn_readfirstlane(t_ >> 6); }
        switch (ph) {
        case 0: p0_prologue(F); break;
        case 2: p2_conv_dt(F); break;
        case 3: p3_ssd_v4<XBC>(F, (bf16_t*)(F.a.ws + WS_BIG)); break;
        case 11: att_mfma2<2>(F, qkv_set(F.a.ws, F.a.out, 0)); break;
        case 13: att_mfma2<1>(F, qkv_set(F.a.ws, F.a.out, 1)); break;
        case 15: att_mfma2<0>(F, qkv_set(F.a.ws, F.a.out, 0)); break;
        default: break;
        }
        __syncthreads();
        for (int i = 0; i < 2; ++i) { GOp op; if (!phase_gemm(F, ph, i, op)) break;
            { int t_ = threadIdx.x; asm volatile("" : "+v"(t_)); F.tid = t_; F.lane = t_ & 63; F.wave = __builtin_amdgcn_readfirstlane(t_ >> 6); }
            run_gemm(F, op); }
        if (ph == 7) {
            const int fb = ((int)gridDim.x == 256) ? 128 : 0;
            cvt_flat(F, F.a.in[I_P], (bf16_t*)(F.a.ws + WS_PB), (size_t)M_ * PLED / 8, fb);
            cvt_flat(F, F.a.in[I_P] + (size_t)M_ * PLED, (bf16_t*)(F.a.ws + WS_PB + 8 * MiB), (size_t)M_ * PLED / 8, fb);
        }
        if (ph0 + 1 < hi + DUP_N) xcd_barrier(bar, bar_epoch);
    }
}

extern "C" void kernel_launch(void* const* d_in, const int* in_sizes, int n_in, void* d_out, int out_size, void* d_ws, size_t ws_size, hipStream_t stream) {
    static int grid = 0;
    if (grid == 0) {
        if (n_in != 21 || out_size != M_ * D_ || ws_size < WS_END) { fprintf(stderr, "kernel_launch: unexpected problem (n_in %d, out %d, ws %zu)\n", n_in, out_size, ws_size); grid = -1; return; }
        int dev = 0, cus = 0, per_cu = 0;
        hipGetDevice(&dev); hipDeviceGetAttribute(&cus, hipDeviceAttributeMultiprocessorCount, dev);
        hipFuncSetAttribute((const void*)mk_fwd, hipFuncAttributeMaxDynamicSharedMemorySize, LDS_BYTES);
        hipOccupancyMaxActiveBlocksPerMultiprocessor(&per_cu, (const void*)mk_fwd, NTHREADS, LDS_BYTES);
        if (per_cu < 1) { fprintf(stderr, "kernel_launch: occupancy query says %d blocks/CU\n", per_cu); per_cu = 1; }
        (void)hipGetLastError();
        grid = cus;
        if (grid > cus * per_cu) grid = cus * per_cu;
    }
    if (grid < 0) return;
    hipMemsetAsync((char*)d_ws + WS_CTL, 0, CTL_ZERO_BYTES, stream);
    Args a{};
    for (int i = 0; i < 21; ++i) a.in[i] = (const float*)d_in[i];
    a.out = (float*)d_out; a.ws = (unsigned char*)d_ws;
    a.ph_lo = 0; a.ph_hi = NPHASE;
    void* kargs[] = {&a};
    hipError_t e = hipLaunchCooperativeKernel((const void*)mk_fwd, dim3(grid), dim3(NTHREADS), kargs, LDS_BYTES, stream);
    if (e != hipSuccess) fprintf(stderr, "cooperative launch failed: %s (grid %d)\n", hipGetErrorString(e), grid);
}
```

```cpp
#include <hip/hip_runtime.h>
#include <cstdio>
#include <cstdint>

#ifndef DUP_PHASE
#define DUP_PHASE 0
#define DUP_N 0
#endif

#define LAS __attribute__((address_space(3)))
#define GAS __attribute__((address_space(1)))
typedef unsigned short bf16_t;
typedef short bf16x8 __attribute__((ext_vector_type(8)));
typedef float f32x4 __attribute__((ext_vector_type(4)));
typedef float f32x2 __attribute__((ext_vector_type(2)));
typedef unsigned u32x4 __attribute__((ext_vector_type(4)));
typedef unsigned u32x2 __attribute__((ext_vector_type(2)));
typedef __bf16 bf16x2_t __attribute__((ext_vector_type(2)));
typedef float f32x16_ __attribute__((ext_vector_type(16)));
typedef float f32x16 __attribute__((ext_vector_type(16)));
typedef short s16x4 __attribute__((ext_vector_type(4)));
typedef short v4i16_t __attribute__((ext_vector_type(4)));

constexpr int M_ = 16384, D_ = 1024, T_ = 4096, NB_ = 4;
constexpr int DIN = 2048, XBC = 3072, INP = 5152;
constexpr int FF = 2816, PLED = 256;
constexpr int QG = 3072, QKVD = 9216;
constexpr float EPS = 1e-6f;
constexpr float LOG2E = 1.4426950408889634f;
constexpr float QSCALE = 0.125f * LOG2E;
constexpr int NWAVES = 8, NTHREADS = 512;

constexpr size_t MiB = 1u << 20;
constexpr size_t WS_CTL = 0, CTL_ZERO_BYTES = 64 * 1024;
constexpr size_t WS_SS = 1 * MiB;
constexpr size_t WS_DT = 2 * MiB;
constexpr size_t WS_GN = 4 * MiB;
constexpr size_t WS_LSE = 6 * MiB;
constexpr size_t WS_WDT = 7 * MiB;
constexpr size_t WS_W = 8 * MiB;
constexpr size_t W_XBC = WS_W;
constexpr size_t W_Z = W_XBC + (size_t)3072 * 1024 * 2;
constexpr size_t W_OUT = W_Z + (size_t)2048 * 1024 * 2;
constexpr size_t W_GU0 = W_OUT + (size_t)1024 * 2048 * 2;
constexpr size_t W_D0 = W_GU0 + (size_t)5632 * 1024 * 2;
constexpr size_t W_PG0 = W_D0 + (size_t)1024 * 2816 * 2;
constexpr size_t W_PP0 = W_PG0 + (size_t)1024 * 1024 * 2;
constexpr size_t W_GU1 = W_PP0 + (size_t)1024 * 256 * 2;
constexpr size_t W_D1 = W_GU1 + (size_t)5632 * 1024 * 2;
constexpr size_t W_QKV = W_D1 + (size_t)1024 * 2816 * 2;
constexpr size_t W_O = W_QKV + (size_t)9216 * 1024 * 2;
constexpr size_t W_PG1 = W_O + (size_t)1024 * 1024 * 2;
constexpr size_t W_PP1 = W_PG1 + (size_t)1024 * 1024 * 2;
constexpr size_t W_END = W_PP1 + (size_t)1024 * 256 * 2;
static_assert(W_GU1 >= 40 * MiB, "layer-0 weights must cover the V buffer");
static_assert(W_END == 80 * MiB, "weight map");
constexpr size_t WS_XB = 80 * MiB;
constexpr size_t WS_BIG = 112 * MiB;
constexpr size_t WS_AUX = 208 * MiB;
constexpr size_t WS_PB = 240 * MiB;
constexpr size_t WS_END = 256 * MiB;

struct QKVSet { bf16_t* q; bf16_t* k; bf16_t* v; };
__device__ __forceinline__ QKVSet qkv_set(unsigned char* ws, float* out, int which) {
    QKVSet r;
    if (which == 0) { bf16_t* B = (bf16_t*)(ws + WS_BIG); r.q = B; r.k = B + (size_t)16 * MiB; r.v = B + (size_t)32 * MiB; }
    else { r.q = (bf16_t*)(ws + WS_XB); r.k = (bf16_t*)out + (size_t)16 * MiB; r.v = (bf16_t*)(ws + WS_W); }
    return r;
}

__device__ __forceinline__ unsigned cvtpk(float lo, float hi) { f32x2 v = {lo, hi}; bf16x2_t b = __builtin_convertvector(v, bf16x2_t); return __builtin_bit_cast(unsigned, b); }
__device__ __forceinline__ float bflo(unsigned w) { return __uint_as_float(w << 16); }
__device__ __forceinline__ float bfhi(unsigned w) { return __uint_as_float(w & 0xffff0000u); }
__device__ __forceinline__ float fast_exp2(float x) { return __builtin_amdgcn_exp2f(x); }
__device__ __forceinline__ float fast_rcp(float x) { return __builtin_amdgcn_rcpf(x); }
__device__ __forceinline__ float sigmoidf_(float x) { return fast_rcp(1.f + fast_exp2(-x * LOG2E)); }
__device__ __forceinline__ float siluf_(float x) { return x * sigmoidf_(x); }
__device__ __forceinline__ float wave_sum(float v) {
#pragma unroll
    for (int o = 1; o < 64; o <<= 1) v += __shfl_xor(v, o);
    return v;
}
__device__ __forceinline__ float rstd_ss(const float* SS, int row) {
    const f32x4* p = (const f32x4*)(SS + (size_t)row * 16);
    const f32x4 a = p[0], b = p[1], c = p[2], d = p[3];
    const float s = ((a.x + a.y) + (a.z + a.w)) + ((b.x + b.y) + (b.z + b.w)) + ((c.x + c.y) + (c.z + c.w)) + ((d.x + d.y) + (d.z + d.w));
    return rsqrtf(s * (1.f / 1024.f) + EPS);
}
#define LDS_WAIT() asm volatile("s_waitcnt lgkmcnt(0)" ::: "memory")
__device__ __forceinline__ unsigned off_b(unsigned row, unsigned ch) { return 256u * row + 16u * (ch ^ (((row & 3) << 2) | ((row >> 2) & 3))); }

namespace pg8 {
constexpr int BM = 256, BK = 64, HALF = 128, HTB = HALF * BK * 2, STAGE_BYTES = 8 * HTB, NXCD = 8, WGM = 8;
__host__ __device__ __forceinline__ int lds_byte(int r, int c) { const int st = (r >> 4) * 2 + (c >> 5), rr = r & 15, cc = c & 31, ob = rr * 64 + cc * 2; return st * 1024 + (ob ^ (((ob >> 9) & 1) << 5)); }
__host__ __device__ __forceinline__ void stage_rc(int b, int& R, int& C) { const int st = b / 1024, sb = b % 1024, swz = sb ^ (((sb >> 9) & 1) << 5); R = (st >> 1) * 16 + swz / 64; C = (st & 1) * 32 + (swz % 64) / 2; }
__host__ __device__ __forceinline__ int perm32(int rho) { const int n = rho >> 4, i = rho & 15; return 8 * (i >> 2) + 4 * n + (i & 3); }

struct Unit { int pm, pn; };
struct Gemm { const bf16_t* A; const bf16_t* Bt; int M, N, K, lda; };

struct StaticOrder {
    int nM, nN, nwg, G, c;
    __host__ __device__ void init(int M, int N, int G_, int c_) { nM = M / BM; nN = N / BM; nwg = nM * nN; G = G_; c = c_; }
    __host__ __device__ bool next(int i, Unit& u) const {
        const long L = (long)i * G + c; if (L >= nwg) return false;
        int wgid = (int)L; { const int q = nwg / NXCD, r = nwg % NXCD, xcd = wgid % NXCD, off = wgid / NXCD; wgid = (xcd < r ? xcd * (q + 1) : r * (q + 1) + (xcd - r) * q) + off; }
        const int nig = WGM * nN, gid = wgid / nig, fm = gid * WGM, gsz = (nM - fm) < WGM ? (nM - fm) : WGM;
        u.pm = fm + ((wgid % nig) % gsz); u.pn = (wgid % nig) / gsz; return true;
    }
};

template <class Epi, class Sched, bool ALIGN_EPI = true, bool SP2 = true>
__device__ __forceinline__ void gemm_phase(LAS unsigned char* lds, const int tid, const Gemm g, const Sched& S, const Epi& E) {
    const int wid = __builtin_amdgcn_readfirstlane(tid >> 6), lane = tid & 63, wr = wid >> 2, wc = wid & 3, fr = lane & 15, fq = lane >> 4;
    const int K = g.K, nt = K / BK, lda = g.lda;
    unsigned voffA[2], voffB[2];
#pragma unroll
    for (int i = 0; i < 2; ++i) { int R, C; stage_rc(tid * 16 + i * 8192, R, C); const int Rb = Epi::PERM ? ((R & ~31) + perm32(R & 31)) : R;
        voffA[i] = (unsigned)(R * lda + C) * 2u; voffB[i] = (unsigned)(Rb * K + C) * 2u; }
    const size_t kstep = (size_t)(BK * 2);
    const size_t hstepA = (size_t)HALF * lda * 2, hstepB = (size_t)HALF * K * 2;
    const size_t tstepA = 2 * hstepA, tstepB = 2 * hstepB;
    const unsigned ldsw = (unsigned)wid * 1024u;
    const int aoff = lds_byte(wr * 64 + fr, fq * 8), boff = lds_byte(wc * 32 + fr, fq * 8);
#define PG8_SA(b, h) (((b) * 2 + (h)) * HTB)
#define PG8_SB(b, h) ((4 + (b) * 2 + (h)) * HTB)
#define PG8_STAGE(bufoff, gbase, voff) do { _Pragma("unroll") for (int _i = 0; _i < 2; ++_i) \
        __builtin_amdgcn_global_load_lds((const unsigned*)((const char*)(gbase) + (voff)[_i]), (LAS unsigned*)(lds + (bufoff) + ldsw + _i * 8192), 16, 0, 0); } while (0)
#define PG8_LDA(dst, b, h) do { _Pragma("unroll") for (int m = 0; m < 4; ++m) _Pragma("unroll") for (int k = 0; k < 2; ++k) dst[m][k] = *(const LAS bf16x8*)(lds + PG8_SA(b, h) + aoff + m * 2048 + k * 1024); } while (0)
#define PG8_LDB(dst, b, h) do { _Pragma("unroll") for (int n = 0; n < 2; ++n) _Pragma("unroll") for (int k = 0; k < 2; ++k) dst[n][k] = *(const LAS bf16x8*)(lds + PG8_SB(b, h) + boff + n * 2048 + k * 1024); } while (0)
#define PG8_MMA(ai, bj, At, Bt) do { __builtin_amdgcn_s_setprio(1); _Pragma("unroll") for (int m = 0; m < 4; ++m) _Pragma("unroll") for (int n = 0; n < 2; ++n) _Pragma("unroll") for (int k = 0; k < 2; ++k) \
        acc[ai][bj][m][n] = __builtin_amdgcn_mfma_f32_16x16x32_bf16(Bt[n][k], At[m][k], acc[ai][bj][m][n], 0, 0, 0); __builtin_amdgcn_s_setprio(0); } while (0)
#define PG8_WAIT_V(n) asm volatile("s_waitcnt vmcnt(" #n ")" ::: "memory")
#define PG8_WAIT_L(n) asm volatile("s_waitcnt lgkmcnt(" #n ")" ::: "memory")
#define PG8_BAR __builtin_amdgcn_s_barrier()
#define PG8_SCHED __builtin_amdgcn_sched_barrier(0)
    Unit cur, nxt; int ui = 0; int tabpm = -1;
    if (!S.next(0, cur)) return;
    f32x4 acc[2][2][4][2];
#pragma unroll
    for (int a = 0; a < 2; ++a)
#pragma unroll
        for (int b = 0; b < 2; ++b)
#pragma unroll
            for (int m = 0; m < 4; ++m)
#pragma unroll
                for (int n = 0; n < 2; ++n) acc[a][b][m][n] = (f32x4){0.f, 0.f, 0.f, 0.f};
    bf16x8 At[4][2], B0[2][2], B1[2][2];
    const char* cA = (const char*)g.A + (size_t)cur.pm * tstepA; const char* cB = (const char*)g.Bt + (size_t)cur.pn * tstepB;
    if constexpr (Epi::SEG) E.unit_begin(cur, ui, tid);
    if constexpr (SP2) {
        PG8_STAGE(PG8_SB(0, 0), cB, voffB); PG8_STAGE(PG8_SB(0, 1), cB + hstepB, voffB); PG8_STAGE(PG8_SA(0, 0), cA, voffA); PG8_STAGE(PG8_SA(0, 1), cA + hstepA, voffA);
        if (wr == 1) PG8_BAR;
        PG8_WAIT_V(2); PG8_BAR;
        PG8_STAGE(PG8_SB(1, 0), cB + kstep, voffB); PG8_STAGE(PG8_SA(1, 0), cA + kstep, voffA); PG8_STAGE(PG8_SB(1, 1), cB + hstepB + kstep, voffB);
        PG8_WAIT_V(6); PG8_BAR;
    } else {
        PG8_STAGE(PG8_SB(0, 0), cB, voffB); PG8_STAGE(PG8_SA(0, 0), cA, voffA); PG8_STAGE(PG8_SB(0, 1), cB + hstepB, voffB); PG8_STAGE(PG8_SA(0, 1), cA + hstepA, voffA);
        if (wr == 1) PG8_BAR;
        PG8_WAIT_V(4); PG8_BAR;
        PG8_STAGE(PG8_SB(1, 0), cB + kstep, voffB); PG8_STAGE(PG8_SA(1, 0), cA + kstep, voffA); PG8_STAGE(PG8_SB(1, 1), cB + hstepB + kstep, voffB);
        PG8_WAIT_V(6); PG8_BAR;
    }
    for (;;) {
        const bool has_next = S.next(ui + 1, nxt);
        const char* nA = has_next ? (const char*)g.A + (size_t)nxt.pm * tstepA : cA; const char* nB = has_next ? (const char*)g.Bt + (size_t)nxt.pn * tstepB : cB;
#pragma clang loop unroll(disable)
        for (int t = 0; t < nt; t += 2) {
            if constexpr (Epi::SEG) { if (t && (t & 7) == 0) { PG8_SCHED; E.seg_scale(acc, (t >> 3) - 1, ui, wr, fr); PG8_SCHED; } }
            const bool last = (t == nt - 2);
            const char* a1 = cA + (size_t)(t + 1) * kstep;
            const char* a2 = last ? nA : cA + (size_t)(t + 2) * kstep; const char* b2 = last ? nB : cB + (size_t)(t + 2) * kstep;
            const char* a3 = a2 + kstep; const char* b3 = b2 + kstep;
            if constexpr (SP2) {
            PG8_LDB(B0, 0, 0); PG8_LDB(B1, 0, 1); PG8_SCHED; PG8_LDA(At, 0, 0); PG8_STAGE(PG8_SA(1, 1), a1 + hstepA, voffA);
            PG8_WAIT_V(8); PG8_WAIT_L(0); PG8_BAR; PG8_MMA(0, 0, At, B0); PG8_MMA(0, 1, At, B1); PG8_BAR; PG8_SCHED;
            PG8_LDA(At, 0, 1); PG8_STAGE(PG8_SB(0, 0), b2, voffB); PG8_STAGE(PG8_SB(0, 1), b2 + hstepB, voffB); PG8_STAGE(PG8_SA(0, 0), a2, voffA);
            PG8_WAIT_V(8); PG8_WAIT_L(0); PG8_BAR; PG8_MMA(1, 0, At, B0); PG8_MMA(1, 1, At, B1); PG8_BAR; PG8_SCHED;
            PG8_LDB(B0, 1, 0); PG8_LDB(B1, 1, 1); PG8_SCHED; PG8_LDA(At, 1, 0); PG8_STAGE(PG8_SA(0, 1), a2 + hstepA, voffA);
            PG8_WAIT_V(8); PG8_WAIT_L(0); PG8_BAR; PG8_MMA(0, 0, At, B0); PG8_MMA(0, 1, At, B1); PG8_BAR; PG8_SCHED;
            PG8_LDA(At, 1, 1); PG8_STAGE(PG8_SB(1, 0), b3, voffB); PG8_STAGE(PG8_SB(1, 1), b3 + hstepB, voffB); PG8_STAGE(PG8_SA(1, 0), a3, voffA);
            PG8_WAIT_V(8); PG8_WAIT_L(0); PG8_BAR; PG8_MMA(1, 0, At, B0); PG8_MMA(1, 1, At, B1); PG8_BAR; PG8_SCHED;
            } else {
            PG8_LDB(B0, 0, 0); PG8_SCHED; PG8_LDA(At, 0, 0); PG8_STAGE(PG8_SA(1, 1), a1 + hstepA, voffA);
            PG8_WAIT_L(8); PG8_BAR; PG8_WAIT_L(0); PG8_MMA(0, 0, At, B0); PG8_BAR; PG8_SCHED;
            PG8_LDB(B1, 0, 1); PG8_STAGE(PG8_SB(0, 0), b2, voffB);
            PG8_BAR; PG8_WAIT_L(0); PG8_MMA(0, 1, At, B1); PG8_BAR;
            PG8_LDA(At, 0, 1); PG8_STAGE(PG8_SA(0, 0), a2, voffA);
            PG8_BAR; PG8_WAIT_L(0); PG8_MMA(1, 0, At, B0); PG8_BAR; PG8_SCHED;
            PG8_STAGE(PG8_SB(0, 1), b2 + hstepB, voffB);
            PG8_WAIT_V(6); PG8_BAR; PG8_MMA(1, 1, At, B1); PG8_BAR;
            PG8_LDB(B0, 1, 0); PG8_SCHED; PG8_LDA(At, 1, 0); PG8_STAGE(PG8_SA(0, 1), a2 + hstepA, voffA);
            PG8_WAIT_L(8); PG8_BAR; PG8_WAIT_L(0); PG8_MMA(0, 0, At, B0); PG8_BAR; PG8_SCHED;
            PG8_LDB(B1, 1, 1); PG8_STAGE(PG8_SB(1, 0), b3, voffB);
            PG8_BAR; PG8_WAIT_L(0); PG8_MMA(0, 1, At, B1); PG8_BAR;
            PG8_LDA(At, 1, 1); PG8_STAGE(PG8_SA(1, 0), a3, voffA);
            PG8_BAR; PG8_WAIT_L(0); PG8_MMA(1, 0, At, B0); PG8_BAR; PG8_SCHED;
            PG8_STAGE(PG8_SB(1, 1), b3 + hstepB, voffB);
            PG8_WAIT_V(6); PG8_BAR; PG8_MMA(1, 1, At, B1); PG8_BAR;
            }
        }
        if constexpr (ALIGN_EPI) { if (wr == 0) PG8_BAR; }
        if constexpr (Epi::SEG) { PG8_SCHED; E.seg_scale(acc, 3, ui, wr, fr); PG8_SCHED; }
        E(acc, cur, tabpm, wr, wc, fr, fq);
        if (!has_next) break;
#pragma unroll
        for (int a = 0; a < 2; ++a)
#pragma unroll
            for (int b = 0; b < 2; ++b)
#pragma unroll
                for (int m = 0; m < 4; ++m)
#pragma unroll
                    for (int n = 0; n < 2; ++n) acc[a][b][m][n] = (f32x4){0.f, 0.f, 0.f, 0.f};
        cur = nxt; cA = nA; cB = nB; ++ui;
        if constexpr (Epi::SEG) E.unit_begin(cur, ui, tid);
        if constexpr (ALIGN_EPI) { if (wr == 1) PG8_BAR; }
    }
    PG8_WAIT_V(0);
    if constexpr (!ALIGN_EPI) { if (wr == 0) PG8_BAR; }
    PG8_BAR;
#undef PG8_SA
#undef PG8_SB
#undef PG8_STAGE
#undef PG8_LDA
#undef PG8_LDB
#undef PG8_MMA
#undef PG8_WAIT_V
#undef PG8_WAIT_L
#undef PG8_BAR
#undef PG8_SCHED
}

typedef f32x4 Acc[2][2][4][2];
__device__ __forceinline__ void rs_fill(const float* SS, int pm, LAS float* tab, int wr, int wc, int fr, int fq) {
    const int tid = (wr * 4 + wc) * 64 + fq * 16 + fr;
    if (tid < 256) tab[tid] = rstd_ss(SS, pm * BM + tid);
    asm volatile("s_waitcnt lgkmcnt(0)" ::: "memory");
    __builtin_amdgcn_s_barrier();
    asm volatile("" ::: "memory");
}

struct EpiStore {
    static constexpr bool PERM = true, SEG = false;
    bf16_t* O; int ldc; const float* SS; LAS float* tab;
    __device__ __forceinline__ void operator()(const Acc& acc, const Unit& u, int& tabpm, int wr, int wc, int fr, int fq) const {
        if (SS && tabpm != u.pm) { rs_fill(SS, u.pm, tab, wr, wc, fr, fq); tabpm = u.pm; }
#pragma unroll
        for (int ai = 0; ai < 2; ++ai)
#pragma unroll
            for (int m = 0; m < 4; ++m) {
                const int row = u.pm * BM + ai * HALF + wr * 64 + m * 16 + fr;
                const float rs = SS ? tab[ai * HALF + wr * 64 + m * 16 + fr] : 1.f;
                bf16_t* rowp = O + (size_t)row * ldc + u.pn * BM + wc * 32 + 8 * fq;
#pragma unroll
                for (int bj = 0; bj < 2; ++bj) {
                    const f32x4 v0 = acc[ai][bj][m][0] * rs, v1 = acc[ai][bj][m][1] * rs;
                    u32x4 w; w.x = cvtpk(v0[0], v0[1]); w.y = cvtpk(v0[2], v0[3]); w.z = cvtpk(v1[0], v1[1]); w.w = cvtpk(v1[2], v1[3]);
                    *(u32x4*)(rowp + bj * HALF) = w;
                }
                asm volatile("" ::: "memory");
            }
    }
};
struct EpiZ {
    static constexpr bool PERM = true, SEG = false;
    bf16_t* Y; const float* SS; float* GN; LAS float* tab;
    __device__ __forceinline__ void operator()(const Acc& acc, const Unit& u, int& tabpm, int wr, int wc, int fr, int fq) const {
        if (tabpm != u.pm) { rs_fill(SS, u.pm, tab, wr, wc, fr, fq); tabpm = u.pm; }
#pragma unroll
        for (int ai = 0; ai < 2; ++ai)
#pragma unroll
            for (int m = 0; m < 4; ++m) {
                const int row = u.pm * BM + ai * HALF + wr * 64 + m * 16 + fr;
                const float rs = tab[ai * HALF + wr * 64 + m * 16 + fr];
                bf16_t* rowp = Y + (size_t)row * XBC + u.pn * BM + wc * 32 + 8 * fq;
                float ssum = 0.f;
#pragma unroll
                for (int bj = 0; bj < 2; ++bj) {
                    const u32x4 yv = *(const u32x4*)(rowp + bj * HALF);
                    const f32x4 z0 = acc[ai][bj][m][0] * rs, z1 = acc[ai][bj][m][1] * rs;
                    float o[8];
                    o[0] = bflo(yv.x) * siluf_(z0[0]); o[1] = bfhi(yv.x) * siluf_(z0[1]); o[2] = bflo(yv.y) * siluf_(z0[2]); o[3] = bfhi(yv.y) * siluf_(z0[3]);
                    o[4] = bflo(yv.z) * siluf_(z1[0]); o[5] = bfhi(yv.z) * siluf_(z1[1]); o[6] = bflo(yv.w) * siluf_(z1[2]); o[7] = bfhi(yv.w) * siluf_(z1[3]);
#pragma unroll
                    for (int j = 0; j < 8; ++j) ssum += o[j] * o[j];
                    u32x4 w; w.x = cvtpk(o[0], o[1]); w.y = cvtpk(o[2], o[3]); w.z = cvtpk(o[4], o[5]); w.w = cvtpk(o[6], o[7]);
                    *(u32x4*)(rowp + bj * HALF) = w;
                }
                ssum += __shfl_xor(ssum, 16); ssum += __shfl_xor(ssum, 32);
                if (fq == 0) GN[(size_t)row * 32 + u.pn * 4 + wc] = ssum;
                asm volatile("" ::: "memory");
            }
    }
};
template <bool GATE, bool FINAL, bool SEG_ = false> struct EpiRes {
    static constexpr bool PERM = true, SEG = SEG_;
    float* xout; const bf16_t* xin; bf16_t* xb; float* SS; const bf16_t* ple;
    const float* GN; LAS float* seg;
    __device__ __forceinline__ void unit_begin(const Unit& u, int ui, int tid) const {
        if (tid < 256) {
            const f32x4* gp = (const f32x4*)(GN + (size_t)(u.pm * BM + tid) * 32);
            float sg[4];
#pragma unroll
            for (int g = 0; g < 4; ++g) { const f32x4 a = gp[2 * g], b = gp[2 * g + 1]; asm volatile("" ::: "memory"); sg[g] = rsqrtf((((a[0] + a[1]) + (a[2] + a[3])) + ((b[0] + b[1]) + (b[2] + b[3]))) * (1.f / 512.f) + EPS); }
            f32x4 o; o[0] = sg[0] / sg[1]; o[1] = sg[1] / sg[2]; o[2] = sg[2] / sg[3]; o[3] = sg[3];
            *(LAS f32x4*)(seg + ((ui & 1) * 256 + tid) * 4) = o;
        }
    }
    __device__ __forceinline__ void seg_scale(Acc& acc, int sgi, int ui, int wr, int fr) const {
#pragma unroll
        for (int ai = 0; ai < 2; ++ai)
#pragma unroll
            for (int m = 0; m < 4; ++m) { const float f = seg[((ui & 1) * 256 + ai * HALF + wr * 64 + m * 16 + fr) * 4 + sgi];
#pragma unroll
                for (int bj = 0; bj < 2; ++bj)
#pragma unroll
                    for (int n = 0; n < 2; ++n) acc[ai][bj][m][n] *= f; }
    }
    __device__ __forceinline__ void operator()(const Acc& acc, const Unit& u, int& tabpm, int wr, int wc, int fr, int fq) const {
#pragma unroll
        for (int ai = 0; ai < 2; ++ai)
#pragma unroll
            for (int m = 0; m < 4; ++m) {
                const int row = u.pm * BM + ai * HALF + wr * 64 + m * 16 + fr;
                const size_t rb = (size_t)row * D_ + u.pn * BM + wc * 32 + 8 * fq;
                float ssum = 0.f;
#pragma unroll
                for (int bj = 0; bj < 2; ++bj) {
                    const size_t off = rb + bj * HALF;
                    const u32x4 xo = *(const u32x4*)(xin + off);
                    f32x4 a0 = acc[ai][bj][m][0], a1 = acc[ai][bj][m][1];
                    if (GATE) { const u32x4 pv = *(const u32x4*)(ple + off);
                        a0[0] = sigmoidf_(a0[0]) * bflo(pv.x); a0[1] = sigmoidf_(a0[1]) * bfhi(pv.x); a0[2] = sigmoidf_(a0[2]) * bflo(pv.y); a0[3] = sigmoidf_(a0[3]) * bfhi(pv.y);
                        a1[0] = sigmoidf_(a1[0]) * bflo(pv.z); a1[1] = sigmoidf_(a1[1]) * bfhi(pv.z); a1[2] = sigmoidf_(a1[2]) * bflo(pv.w); a1[3] = sigmoidf_(a1[3]) * bfhi(pv.w); }
                    f32x4 x0, x1;
                    x0[0] = bflo(xo.x) + a0[0]; x0[1] = bfhi(xo.x) + a0[1]; x0[2] = bflo(xo.y) + a0[2]; x0[3] = bfhi(xo.y) + a0[3];
                    x1[0] = bflo(xo.z) + a1[0]; x1[1] = bfhi(xo.z) + a1[1]; x1[2] = bflo(xo.w) + a1[2]; x1[3] = bfhi(xo.w) + a1[3];
                    ssum += ((x0[0] * x0[0] + x0[1] * x0[1]) + (x0[2] * x0[2] + x0[3] * x0[3])) + ((x1[0] * x1[0] + x1[1] * x1[1]) + (x1[2] * x1[2] + x1[3] * x1[3]));
                    if (FINAL) { *(f32x4*)(xout + off) = x0; *(f32x4*)(xout + off + 4) = x1; }
                    else { u32x4 w; w.x = cvtpk(x0[0], x0[1]); w.y = cvtpk(x0[2], x0[3]); w.z = cvtpk(x1[0], x1[1]); w.w = cvtpk(x1[2], x1[3]); *(u32x4*)(xb + off) = w; }
                }
                ssum += __shfl_xor(ssum, 16); ssum += __shfl_xor(ssum, 32);
                if (SS && fq == 0) SS[(size_t)row * 16 + u.pn * 4 + wc] = ssum;
                if (m & 1) asm volatile("" ::: "memory");
            }
    }
};
struct EpiGU {
    static constexpr bool PERM = true, SEG = false;
    bf16_t* H; const float* SS; LAS float* tab;
    __device__ __forceinline__ void operator()(const Acc& acc, const Unit& u, int& tabpm, int wr, int wc, int fr, int fq) const {
        if (tabpm != u.pm) { rs_fill(SS, u.pm, tab, wr, wc, fr, fq); tabpm = u.pm; }
#pragma unroll
        for (int ai = 0; ai < 2; ++ai)
#pragma unroll
            for (int m = 0; m < 4; ++m) {
                const int row = u.pm * BM + ai * HALF + wr * 64 + m * 16 + fr;
                const float rs = tab[ai * HALF + wr * 64 + m * 16 + fr];
                float o[8];
#pragma unroll
                for (int n = 0; n < 2; ++n) {
                    const f32x4 gq = acc[ai][0][m][n] * rs, uq = acc[ai][1][m][n] * rs;
#pragma unroll
                    for (int j = 0; j < 4; ++j) o[4 * n + j] = siluf_(gq[j]) * uq[j];
                }
                u32x4 w; w.x = cvtpk(o[0], o[1]); w.y = cvtpk(o[2], o[3]); w.z = cvtpk(o[4], o[5]); w.w = cvtpk(o[6], o[7]);
                *(u32x4*)(H + (size_t)row * FF + u.pn * HALF + wc * 32 + 8 * fq) = w;
                asm volatile("" ::: "memory");
            }
    }
};
struct EpiQKV {
    static constexpr bool PERM = true, SEG = false;
    bf16_t* Oq; long dk, dv; const float* SS; const float* qg; const float* kg; LAS float* tab;
    __device__ __forceinline__ void operator()(const Acc& acc, const Unit& u, int& tabpm, int wr, int wc, int fr, int fq) const {
        const int tid = (wr * 4 + wc) * 64 + fq * 16 + fr;
        f32x4 s0, s1, s2, s3;
        const bool fill = (tabpm != u.pm); tabpm = u.pm;
        if (fill && tid < 256) { const f32x4* p = (const f32x4*)(SS + (size_t)(u.pm * BM + tid) * 16); s0 = p[0]; s1 = p[1]; s2 = p[2]; s3 = p[3]; }
        const int type = u.pn >> 2;
        bf16_t* O = Oq + ((type == 1) ? dk : (type == 2) ? dv : 0l);
        f32x4 gn[2][2];
        const float* gp = (type == 0) ? qg : kg;
#pragma unroll
        for (int bj = 0; bj < 2; ++bj)
#pragma unroll
            for (int n = 0; n < 2; ++n) gn[bj][n] = (type < 2) ? *(const f32x4*)(gp + 32 * bj + 8 * fq + 4 * n) : (f32x4){1.f, 1.f, 1.f, 1.f};
        float f[8];
        if (type < 2) {
#pragma unroll
            for (int i = 0; i < 8; ++i) { const int ai = i >> 2, m = i & 3; f32x4 q = acc[ai][0][m][0] * acc[ai][0][m][0];
                q += acc[ai][0][m][1] * acc[ai][0][m][1]; q += acc[ai][1][m][0] * acc[ai][1][m][0]; q += acc[ai][1][m][1] * acc[ai][1][m][1];
                f[i] = (q[0] + q[1]) + (q[2] + q[3]); }
#pragma unroll
            for (int i = 0; i < 8; ++i) f[i] += __shfl_xor(f[i], 16);
#pragma unroll
            for (int i = 0; i < 8; ++i) f[i] += __shfl_xor(f[i], 32);
        }
        if (fill) {
        if (tid < 256) { const float s = ((s0.x + s0.y) + (s0.z + s0.w)) + ((s1.x + s1.y) + (s1.z + s1.w)) + ((s2.x + s2.y) + (s2.z + s2.w)) + ((s3.x + s3.y) + (s3.z + s3.w));
            tab[tid] = rsqrtf(s * (1.f / 1024.f) + EPS); }
        asm volatile("s_waitcnt lgkmcnt(0)" ::: "memory");
        __builtin_amdgcn_s_barrier();
        asm volatile("" ::: "memory");
        }
#pragma unroll
        for (int i = 0; i < 8; ++i) { const float rs = tab[(i >> 2) * HALF + wr * 64 + (i & 3) * 16 + fr];
            if (type < 2) { float rr = rs * rsqrtf(rs * rs * f[i] * (1.f / 64.f) + EPS); if (type == 0) rr *= QSCALE; f[i] = rr; } else f[i] = rs; }
#pragma unroll
        for (int ai = 0; ai < 2; ++ai)
#pragma unroll
            for (int m = 0; m < 4; ++m) {
                const int row = u.pm * BM + ai * HALF + wr * 64 + m * 16 + fr;
                const float rr = f[ai * 4 + m];
                bf16_t* rowp = O + (size_t)row * D_ + (u.pn & 3) * BM + wc * 64 + 8 * fq;
#pragma unroll
                for (int bj = 0; bj < 2; ++bj) {
                    const f32x4 v0 = acc[ai][bj][m][0] * gn[bj][0] * rr, v1 = acc[ai][bj][m][1] * gn[bj][1] * rr;
                    u32x4 w; w.x = cvtpk(v0[0], v0[1]); w.y = cvtpk(v0[2], v0[3]); w.z = cvtpk(v1[0], v1[1]); w.w = cvtpk(v1[2], v1[3]);
                    *(u32x4*)(rowp + bj * 32) = w;
                }
                if (m & 1) asm volatile("" ::: "memory");
            }
    }
};
}

#define XB_TMO      128
#define XB_XCNT(j)  (256  + 64 * (j))
#define XB_XSUB(j)  (1280 + 64 * (j))
#define XB_XGEN(j)  (2304 + 64 * (j))
#define XB_TOP      3328
#define XB_TOPGEN   3392
#define XCD_BAR_WORDS 3456
#define XB_SPIN_CAP (1u << 20)
__device__ __forceinline__ unsigned xb_ld(unsigned* p)              { return __hip_atomic_load(p, __ATOMIC_RELAXED, __HIP_MEMORY_SCOPE_AGENT); }
__device__ __forceinline__ unsigned xb_add(unsigned* p, unsigned v) { return __hip_atomic_fetch_add(p, v, __ATOMIC_RELAXED, __HIP_MEMORY_SCOPE_AGENT); }
__device__ __forceinline__ unsigned xb_xcc_id() { return (unsigned)__builtin_amdgcn_s_getreg((3 << 11) | 20) & 0xFu; }
#define XB_SPIN(cond, bar) do { unsigned _sp = 0; while (cond) { __builtin_amdgcn_s_sleep(1); \
    if ((++_sp & 255u) == 0u) { if (xb_ld(&(bar)[XB_TMO])) break; if (_sp > XB_SPIN_CAP) { atomicAdd(&(bar)[XB_TMO], 1u); break; } } } } while (0)
struct XcdBarrier { unsigned* bar; unsigned x; volatile LAS unsigned* st; };
__device__ __forceinline__ XcdBarrier xcd_barrier_post(unsigned* bar, volatile LAS unsigned* st) {
    XcdBarrier b; b.bar = bar; b.x = xb_xcc_id(); b.st = st;
    if (threadIdx.x == 0) (void)xb_add(&bar[XB_XCNT(b.x)], 1u);
    return b;
}
__device__ __forceinline__ void xcd_barrier_complete(unsigned* bar, unsigned x, unsigned& nloc, unsigned& nx) {
    const unsigned G = gridDim.x * gridDim.y * gridDim.z;
    unsigned sum, cnt, mine, sp = 0u;
    for (;;) {
        sum = 0u; cnt = 0u; mine = 0u;
#pragma unroll
        for (unsigned j = 0; j < 16; ++j) { const unsigned c = xb_ld(&bar[XB_XCNT(j)]); sum += c; cnt += (c > 0u) ? 1u : 0u; mine = (j == x) ? c : mine; }
        if (sum == G) break;
        __builtin_amdgcn_s_sleep(1);
        if ((++sp & 255u) == 0u) { if (xb_ld(&bar[XB_TMO])) break; if (sp > XB_SPIN_CAP) { atomicAdd(&bar[XB_TMO], 1u); break; } }
    }
    nloc = mine > 0u ? mine : 1u; nx = cnt > 0u ? cnt : 1u;
}
__device__ __forceinline__ void xcd_barrier(const XcdBarrier& b, unsigned& epoch) {
    asm volatile("s_waitcnt vmcnt(0)" ::: "memory");
    __syncthreads();
    if (threadIdx.x == 0) {
        unsigned* bar = b.bar;
        __builtin_amdgcn_s_waitcnt(0);
        unsigned nloc = b.st[0], nx = b.st[1];
        if (nloc == 0u) { xcd_barrier_complete(bar, b.x, nloc, nx); b.st[0] = nloc; b.st[1] = nx; }
        const unsigned old = xb_add(&bar[XB_XSUB(b.x)], 1u);
        if ((old + 1u) % nloc == 0u) {
            __builtin_amdgcn_fence(__ATOMIC_RELEASE, "agent");
            asm volatile("s_waitcnt vmcnt(0)" ::: "memory");
            (void)xb_add(&bar[XB_TOP], 1u);
        }
        XB_SPIN(xb_ld(&bar[XB_TOP]) < nx * (epoch + 1u), bar);
        __builtin_amdgcn_fence(__ATOMIC_ACQUIRE, "agent");
        asm volatile("s_waitcnt vmcnt(0)" ::: "memory");
    }
    ++epoch;
    __syncthreads();
}

constexpr int RING_BYTES = 131072;
constexpr int LDS_BYTES = 163840;
constexpr int LDSCTL_OFF = LDS_BYTES - 128, MISC_OFF = LDSCTL_OFF;

struct Args { const float* in[21]; float* out; unsigned char* ws; int ph_lo, ph_hi; };
enum { I_X = 0, I_P, I_NMIX, I_NFFN, I_WIN, I_CW, I_CB, I_DTB, I_ALOG, I_DSKIP, I_SNW, I_WOUT, I_WQKV, I_QN, I_KN, I_WO, I_FG, I_FU, I_FD, I_PP, I_PG };

struct Frame {
    LAS unsigned char* lds;
    int tid, lane, wave;
    const Args& a;
    __device__ __forceinline__ Frame(const Args& a_) : a(a_) {}
};

struct WDesc { const float* src; const float* src2; const float* gain; bf16_t* dst; int ld, K, nslots, mode, colbase; };
constexpr int NWMAT = 13;
__device__ __forceinline__ WDesc wdesc(const Frame& F, int mi) {
    WDesc w; w.src2 = nullptr; w.gain = nullptr; w.mode = 0; w.colbase = 0;
    unsigned char* ws = F.a.ws;
    switch (mi) {
    case 0: w.src = F.a.in[I_WIN]; w.ld = INP; w.K = 1024; w.nslots = 3072; w.colbase = 2048; w.gain = F.a.in[I_NMIX]; w.dst = (bf16_t*)(ws + W_XBC); break;
    case 1: w.src = F.a.in[I_WIN]; w.ld = INP; w.K = 1024; w.nslots = 2048; w.colbase = 0; w.gain = F.a.in[I_NMIX]; w.dst = (bf16_t*)(ws + W_Z); break;
    case 2: w.src = F.a.in[I_WOUT]; w.ld = 1024; w.K = 2048; w.nslots = 1024; w.gain = F.a.in[I_SNW]; w.dst = (bf16_t*)(ws + W_OUT); break;
    case 3: w.src = F.a.in[I_FG]; w.src2 = F.a.in[I_FU]; w.ld = FF; w.K = 1024; w.nslots = 5632; w.mode = 1; w.gain = F.a.in[I_NFFN]; w.dst = (bf16_t*)(ws + W_GU0); break;
    case 4: w.src = F.a.in[I_FG] + (size_t)1024 * FF; w.src2 = F.a.in[I_FU] + (size_t)1024 * FF; w.ld = FF; w.K = 1024; w.nslots = 5632; w.mode = 1; w.gain = F.a.in[I_NFFN] + 1024; w.dst = (bf16_t*)(ws + W_GU1); break;
    case 5: w.src = F.a.in[I_FD]; w.ld = 1024; w.K = FF; w.nslots = 1024; w.dst = (bf16_t*)(ws + W_D0); break;
    case 6: w.src = F.a.in[I_FD] + (size_t)FF * 1024; w.ld = 1024; w.K = FF; w.nslots = 1024; w.dst = (bf16_t*)(ws + W_D1); break;
    case 7: w.src = F.a.in[I_WQKV]; w.ld = QKVD; w.K = 1024; w.nslots = QKVD; w.mode = 2; w.gain = F.a.in[I_NMIX] + 1024; w.dst = (bf16_t*)(ws + W_QKV); break;
    case 8: w.src = F.a.in[I_WO]; w.ld = 1024; w.K = 1024; w.nslots = 1024; w.dst = (bf16_t*)(ws + W_O); break;
    case 9: w.src = F.a.in[I_PG]; w.ld = 1024; w.K = 1024; w.nslots = 1024; w.dst = (bf16_t*)(ws + W_PG0); break;
    case 10: w.src = F.a.in[I_PG] + (size_t)1024 * 1024; w.ld = 1024; w.K = 1024; w.nslots = 1024; w.dst = (bf16_t*)(ws + W_PG1); break;
    case 11: w.src = F.a.in[I_PP]; w.ld = 1024; w.K = 256; w.nslots = 1024; w.dst = (bf16_t*)(ws + W_PP0); break;
    default: w.src = F.a.in[I_PP] + (size_t)256 * 1024; w.ld = 1024; w.K = 256; w.nslots = 1024; w.dst = (bf16_t*)(ws + W_PP1); break;
    }
    return w;
}
__device__ __forceinline__ void cvt_item(const WDesc& w, int item, LAS float* scr, int lane) {
    const int nkb = w.K / 64, sb = item / nkb, kb = item % nkb, slot0 = sb * 32, k0 = kb * 64;
    const float* src = w.src; int col0;
    if (w.mode == 0) col0 = w.colbase + slot0;
    else if (w.mode == 1) { const int tile = slot0 >> 8, t = slot0 & 255; if (t < 128) col0 = tile * 128 + t; else { src = w.src2; col0 = tile * 128 + t - 128; } }
    else { const int g = slot0 / QG, r = slot0 % QG, tile = r >> 8, t = r & 255, bj = t >> 7, wc = (t & 127) >> 5; col0 = g * QG + tile * 256 + 64 * wc + 32 * bj; }
    float tv[32];
#pragma unroll
    for (int i = 0; i < 32; ++i) { const int kk = 2 * i + (lane >> 5); tv[i] = __builtin_nontemporal_load(&src[(size_t)(k0 + kk) * w.ld + col0 + (lane & 31)]); }
    if (w.gain) {
#pragma unroll
        for (int i = 0; i < 32; ++i) tv[i] *= w.gain[k0 + 2 * i + (lane >> 5)];
    }
#pragma unroll
    for (int i = 0; i < 32; ++i) scr[(2 * i + (lane >> 5)) * 33 + (lane & 31)] = tv[i];
    LDS_WAIT(); asm volatile("" ::: "memory");
    const int c = lane & 7;
#pragma unroll
    for (int j = 0; j < 4; ++j) { const int n = (lane >> 3) + 8 * j; const LAS float* s = scr + (8 * c) * 33 + n;
        u32x4 o; o.x = cvtpk(s[0 * 33], s[1 * 33]); o.y = cvtpk(s[2 * 33], s[3 * 33]); o.z = cvtpk(s[4 * 33], s[5 * 33]); o.w = cvtpk(s[6 * 33], s[7 * 33]);
        *(u32x4*)(w.dst + (size_t)(slot0 + n) * w.K + k0 + 8 * c) = o; }
    LDS_WAIT(); asm volatile("" ::: "memory");
}
__device__ __forceinline__ void cvt_flat(const Frame& F, const float* src, bf16_t* dst, size_t n8, int first_bid = 0) {
    if ((int)blockIdx.x < first_bid) return;
    for (size_t i = (size_t)((int)blockIdx.x - first_bid) * NTHREADS + F.tid; i < n8; i += (size_t)((int)gridDim.x - first_bid) * NTHREADS) {
        const f32x4 a = __builtin_nontemporal_load((const f32x4*)(src + i * 8)), b = __builtin_nontemporal_load((const f32x4*)(src + i * 8 + 4));
        u32x4 w; w.x = cvtpk(a[0], a[1]); w.y = cvtpk(a[2], a[3]); w.z = cvtpk(b[0], b[1]); w.w = cvtpk(b[2], b[3]);
        *(u32x4*)(dst + i * 8) = w;
    }
}
__device__ __forceinline__ void cvt_range(const Frame& F, int mi, int lo, int hi, int first_bid) {
    if ((int)blockIdx.x < first_bid) return;
    LAS float* scr = (LAS float*)(F.lds + F.wave * 16384);
    const WDesc w = wdesc(F, mi);
    const int gw = ((int)blockIdx.x - first_bid) * NWAVES + F.wave, NGW = ((int)gridDim.x - first_bid) * NWAVES;
    for (int it = lo + gw; it < hi; it += NGW) cvt_item(w, it, scr, F.lane);
}
__device__ __forceinline__ void jit_weights(const Frame& F, int ph, bool early) {
    const int fb = ((int)gridDim.x == 256) ? 128 : 0;
    if (early) {
        switch (ph) {
        case 4: cvt_range(F, 2, 0, 32 * 32, 0); break;
        case 6: cvt_range(F, 3, 0, 176 * 16, 0); break;
        case 9: cvt_range(F, 7, 2 * 96 * 16, 3 * 96 * 16, 0); break;
        case 15: cvt_range(F, 8, 0, 32 * 16, 0); break;
        case 16: cvt_range(F, 4, 0, 176 * 16, 0); break;
        default: break;
        }
        return;
    }
    switch (ph) {
    case 3: cvt_range(F, 1, 0, 64 * 16, 0); break;
    case 7: cvt_range(F, 5, 0, 32 * 44, fb); cvt_range(F, 11, 0, 32 * 4, fb); cvt_range(F, 9, 0, 32 * 16, fb); break;
    case 10: cvt_range(F, 7, 1 * 96 * 16, 2 * 96 * 16, 0); break;
    case 11: cvt_range(F, 7, 0, 96 * 16, 0); break;
    case 17: cvt_range(F, 6, 0, 32 * 44, fb); cvt_range(F, 12, 0, 32 * 4, fb); cvt_range(F, 10, 0, 32 * 16, fb); break;
    default: break;
    }
}
__device__ __forceinline__ void p0_prologue(const Frame& F) {
    LAS float* scr = (LAS float*)(F.lds + F.wave * 16384);
    const int gw = (int)blockIdx.x * NWAVES + F.wave, NGW = (int)gridDim.x * NWAVES;
    int base = 0;
    {
        const WDesc w = wdesc(F, 0);
        const int nit = (w.nslots / 32) * (w.K / 64);
        int first = (gw - (base % NGW) + NGW) % NGW;
        for (int it = first; it < nit; it += NGW) cvt_item(w, it, scr, F.lane);
        base += nit;
    }
    const float* x = F.a.in[I_X]; bf16_t* XB = (bf16_t*)(F.a.ws + WS_XB); float* SS = (float*)(F.a.ws + WS_SS);
    for (int row = gw; row < M_; row += NGW) {
        const f32x4* xr = (const f32x4*)(x + (size_t)row * D_) + F.lane;
        f32x4 v[4]; float s = 0.f;
#pragma unroll
        for (int j = 0; j < 4; ++j) { v[j] = __builtin_nontemporal_load(&xr[64 * j]); s += (v[j].x * v[j].x + v[j].y * v[j].y) + (v[j].z * v[j].z + v[j].w * v[j].w); }
        s = wave_sum(s);
        u32x2* o8 = (u32x2*)(XB + (size_t)row * D_) + F.lane;
#pragma unroll
        for (int j = 0; j < 4; ++j) { u32x2 w; w.x = cvtpk(v[j].x, v[j].y); w.y = cvtpk(v[j].z, v[j].w); o8[64 * j] = w; }
        if (F.lane < 16) SS[(size_t)row * 16 + F.lane] = (F.lane == 0) ? s : 0.f;
    }
    bf16_t* WH = (bf16_t*)(F.a.ws + WS_WDT); bf16_t* WL = WH + 32 * 1024;
    for (int i = (int)blockIdx.x * NTHREADS + F.tid; i < 1024 * 32; i += (int)gridDim.x * NTHREADS) { const int k = i >> 5, j = i & 31;
        const float v = F.a.in[I_WIN][(size_t)k * INP + 5120 + j] * F.a.in[I_NMIX][k];
        const unsigned hi = cvtpk(v, 0.f) & 0xffffu; const float r = v - __uint_as_float(hi << 16);
        WH[j * 1024 + k] = (bf16_t)hi; WL[j * 1024 + k] = (bf16_t)(cvtpk(r, 0.f) & 0xffffu); }
}

constexpr int CBT_TILE_ELEMS = 64 * 16;
__device__ __forceinline__ void p2_conv_dt(const Frame& F) {
    const bf16_t* BIG = (const bf16_t*)(F.a.ws + WS_BIG); bf16_t* BC = (bf16_t*)(F.a.ws + WS_AUX); bf16_t* CBT = (bf16_t*)F.a.out;
    const float* cw = F.a.in[I_CW]; const float* cb = F.a.in[I_CB];
    LAS unsigned char* L = F.lds;
    const int tid = F.tid, lane = F.lane, wave = F.wave, ql = lane & 31, hh = lane >> 5;
    for (int job = (int)blockIdx.x; job < NB_ * 32 * 4; job += (int)gridDim.x) {
        const int g = job & 3, c = (job >> 2) & 31, b = job >> 7;
        const size_t r0 = (size_t)b * T_ + (size_t)c * 128;
#pragma unroll 2
        for (int i = 0; i < 8; ++i) {
            const int idx = tid + 512 * i, row = idx >> 5, cc = idx & 31, isC = cc >> 4, ch = cc & 15;
            const int xcol = 2048 + isC * 512 + g * 128 + ch * 8, t = c * 128 + row;
            float a[8];
            { const f32x4 b0 = *(const f32x4*)(cb + xcol), b1 = *(const f32x4*)(cb + xcol + 4);
              a[0] = b0[0]; a[1] = b0[1]; a[2] = b0[2]; a[3] = b0[3]; a[4] = b1[0]; a[5] = b1[1]; a[6] = b1[2]; a[7] = b1[3]; }
#pragma unroll
            for (int k = 0; k < 4; ++k) {
                if (t - 3 + k >= 0) {
                    const u32x4 r = *(const u32x4*)(BIG + (r0 + row - 3 + k) * XBC + xcol);
                    const f32x4 w0 = *(const f32x4*)(cw + k * XBC + xcol), w1 = *(const f32x4*)(cw + k * XBC + xcol + 4);
                    a[0] += w0[0] * bflo(r.x); a[1] += w0[1] * bfhi(r.x); a[2] += w0[2] * bflo(r.y); a[3] += w0[3] * bfhi(r.y);
                    a[4] += w1[0] * bflo(r.z); a[5] += w1[1] * bfhi(r.z); a[6] += w1[2] * bflo(r.w); a[7] += w1[3] * bfhi(r.w);
                }
            }
#pragma unroll
            for (int j = 0; j < 8; ++j) a[j] = siluf_(a[j]);
            u32x4 w; w.x = cvtpk(a[0], a[1]); w.y = cvtpk(a[2], a[3]); w.z = cvtpk(a[4], a[5]); w.w = cvtpk(a[6], a[7]);
            *(LAS u32x4*)(L + isC * 32768 + off_b(row, ch)) = w;
        }
        __syncthreads();
#pragma unroll 1
        for (int ti = wave; ti < 10; ti += 8) {
            const int lt = (ti >= 6) ? 3 : (ti >= 3) ? 2 : (ti >= 1) ? 1 : 0, st = ti - lt * (lt + 1) / 2;
            f32x16_ S;
#pragma unroll
            for (int i = 0; i < 16; ++i) S[i] = 0.f;
#pragma unroll
            for (int ks = 0; ks < 8; ++ks) { const bf16x8 av = *(const LAS bf16x8*)(L + off_b(32 * st + ql, 2 * ks + hh)); const bf16x8 cv = *(const LAS bf16x8*)(L + 32768 + off_b(32 * lt + ql, 2 * ks + hh));
                S = __builtin_amdgcn_mfma_f32_32x32x16_bf16(av, cv, S, 0, 0, 0); }
            u32x4 w0, w1;
            w0.x = cvtpk(S[0], S[1]); w0.y = cvtpk(S[2], S[3]); w0.z = cvtpk(S[4], S[5]); w0.w = cvtpk(S[6], S[7]);
            w1.x = cvtpk(S[8], S[9]); w1.y = cvtpk(S[10], S[11]); w1.z = cvtpk(S[12], S[13]); w1.w = cvtpk(S[14], S[15]);
            bf16_t* dst = CBT + ((size_t)job * 10 + ti) * CBT_TILE_ELEMS + lane * 16;
            *(u32x4*)dst = w0; *(u32x4*)(dst + 8) = w1;
        }
        { const unsigned blk = (lane >> 4) & 1, q4 = (lane & 15) >> 2, p4 = lane & 3;
          bf16_t* fb = BC + (size_t)job * 32768 + lane * 8;
#pragma unroll
          for (int i = 0; i < 4; ++i) { const int f = wave + 8 * i, n8 = f >> 3, k8 = f & 7;
              const s16x4 t0 = __builtin_bit_cast(s16x4, __builtin_amdgcn_ds_read_tr16_b64_v4i16((LAS v4i16_t*)(L + off_b(16 * k8 + 8 * hh + q4, 4 * n8 + 2 * blk + (p4 >> 1)) + 8 * (p4 & 1))));
              const s16x4 t1 = __builtin_bit_cast(s16x4, __builtin_amdgcn_ds_read_tr16_b64_v4i16((LAS v4i16_t*)(L + off_b(16 * k8 + 8 * hh + 4 + q4, 4 * n8 + 2 * blk + (p4 >> 1)) + 8 * (p4 & 1))));
              const bf16x8 bfr = __builtin_shufflevector(t0, t1, 0, 1, 2, 3, 4, 5, 6, 7);
              *(bf16x8*)(fb + f * 512) = bfr;
              const u32x2 clo = *(const LAS u32x2*)(L + 32768 + off_b(32 * n8 + ql, 2 * k8) + 8 * hh), chi = *(const LAS u32x2*)(L + 32768 + off_b(32 * n8 + ql, 2 * k8 + 1) + 8 * hh);
              const u32x4 cfr = {clo.x, clo.y, chi.x, chi.y};
              *(u32x4*)(fb + 16384 + f * 512) = cfr; } }
        __syncthreads();
    }
    __syncthreads();
    const bf16_t* XBp = (const bf16_t*)(F.a.ws + WS_XB); const float* SSp = (const float*)(F.a.ws + WS_SS);
    const bf16_t* WH = (const bf16_t*)(F.a.ws + WS_WDT); const bf16_t* WL = WH + 32 * 1024; float* DT = (float*)(F.a.ws + WS_DT);
    const int kq = F.wave & 3, isub = F.wave >> 2;
    LAS float* part = (LAS float*)F.lds;
    for (int it2 = (int)blockIdx.x; it2 < M_ / 64; it2 += (int)gridDim.x) {
        const int item = it2 * 2 + isub;
        const bf16_t* xr = XBp + (size_t)(item * 32 + ql) * D_ + kq * 256 + 8 * hh;
        const bf16_t* whp = WH + ql * 1024 + kq * 256 + 8 * hh; const bf16_t* wlp = WL + ql * 1024 + kq * 256 + 8 * hh;
        f32x16_ acc;
#pragma unroll
        for (int i = 0; i < 16; ++i) acc[i] = 0.f;
#pragma unroll 8
        for (int ks = 0; ks < 16; ++ks) {
            const bf16x8 ah = *(const bf16x8*)(xr + 16 * ks);
            const bf16x8 bh = *(const bf16x8*)(whp + 16 * ks), bl = *(const bf16x8*)(wlp + 16 * ks);
            acc = __builtin_amdgcn_mfma_f32_32x32x16_bf16(ah, bh, acc, 0, 0, 0);
            acc = __builtin_amdgcn_mfma_f32_32x32x16_bf16(ah, bl, acc, 0, 0, 0);
        }
        LAS float* mine = part + ((isub * 4 + kq) * 17) * 64 + F.lane;
#pragma unroll
        for (int i = 0; i < 16; ++i) mine[i * 64] = acc[i];
        __syncthreads();
        if (kq == 0) {
            const LAS float* p0 = part + (isub * 4 * 17) * 64 + F.lane;
            const float rstd = rstd_ss(SSp, item * 32 + ql), bias = F.a.in[I_DTB][ql];
#pragma unroll
            for (int r = 0; r < 16; ++r) { const int rr = (r & 3) + 8 * (r >> 2) + 4 * hh;
                const float a = (p0[r * 64] + p0[(17 + r) * 64]) + (p0[(34 + r) * 64] + p0[(51 + r) * 64]);
                const float v = a * __shfl(rstd, rr) + bias;
                DT[(size_t)(item * 32 + rr) * 32 + ql] = v > 20.f ? v : log1pf(__expf(v)); }
        }
        __syncthreads();
    }
}

constexpr int VP = 192;
__device__ __forceinline__ float xhalf_max(float m) { auto rr = __builtin_amdgcn_permlane32_swap(__float_as_uint(m), __float_as_uint(m), false, false); return fmaxf(__uint_as_float(rr[0]), __uint_as_float(rr[1])); }

__device__ __forceinline__ void att_scores(const bf16x8 (&kf)[4], const bf16x8 (&qf)[4], int ti, int ql, int hh, float slope2, float& mx, float& lsum, f32x16& o0, f32x16& o1, u32x4 (&pw)[2]) {
    const int dbase = 128 - 32 * ti + ql - 4 * hh;
    const float b0 = -slope2 * (float)dbase - mx;
    f32x16 sa;
#pragma unroll
    for (int i = 0; i < 16; ++i) sa[i] = b0;
    __builtin_amdgcn_s_setprio(1);
#pragma unroll
    for (int s = 0; s < 4; ++s) sa = __builtin_amdgcn_mfma_f32_32x32x16_bf16(kf[s], qf[s], sa, 0, 0, 0);
    __builtin_amdgcn_s_setprio(0);
#pragma unroll
    for (int i = 0; i < 16; ++i) sa[i] = fmaf(slope2, (float)((i & 3) + 8 * (i >> 2)), sa[i]);
    if (ti <= 0 || ti >= 4) {
#pragma unroll
        for (int i = 0; i < 16; ++i) { const int dist = dbase - ((i & 3) + 8 * (i >> 2)); if ((unsigned)dist > 128u) sa[i] = -3e30f; }
    }
    float rm = fmaxf(fmaxf(sa[0], sa[1]), fmaxf(sa[2], sa[3]));
#pragma unroll
    for (int i = 4; i < 16; i += 4) rm = fmaxf(rm, fmaxf(fmaxf(sa[i], sa[i + 1]), fmaxf(sa[i + 2], sa[i + 3])));
    rm = xhalf_max(rm);
    if (__any(rm > 6.f)) {
        const float sh = (rm > 6.f) ? rm : 0.f, alpha = fast_exp2(-sh);
        mx += sh; lsum *= alpha;
#pragma unroll
        for (int i = 0; i < 16; ++i) { sa[i] -= sh; o0[i] *= alpha; o1[i] *= alpha; }
    }
    float ps = 0.f;
#pragma unroll
    for (int i = 0; i < 16; ++i) { const float pv = fast_exp2(sa[i]); sa[i] = pv; ps += pv; }
    lsum += ps;
#pragma unroll
    for (int s = 0; s < 2; ++s) { pw[s].x = cvtpk(sa[8 * s], sa[8 * s + 1]); pw[s].y = cvtpk(sa[8 * s + 2], sa[8 * s + 3]); pw[s].z = cvtpk(sa[8 * s + 4], sa[8 * s + 5]); pw[s].w = cvtpk(sa[8 * s + 6], sa[8 * s + 7]); }
}
template <int G_> __device__ __forceinline__ void att_mfma2(const Frame& F, const QKVSet qs) {
    constexpr int d = (G_ == 0) ? 1 : (G_ == 1) ? 4 : 16, lu = T_ / d, ntile = lu / 64, nitems = NB_ * 16 * d * ntile;
    const bf16_t* Qb = qs.q; const bf16_t* Kb = qs.k; const bf16_t* Vb = qs.v; bf16_t* OUT = (bf16_t*)(F.a.ws + WS_AUX); float* LSE = (float*)(F.a.ws + WS_LSE);
    const int lane = F.lane, ql = lane & 31, hh = lane >> 5;
    LAS unsigned char* Vs = F.lds + F.wave * 20480;
    LAS float* Os = (LAS float*)(Vs + 6144); LAS float* wtab = (LAS float*)(Vs + 6144 + 32 * 272);
    const int gw = (int)blockIdx.x * NWAVES + F.wave, NGW = (int)gridDim.x * NWAVES;
    const int trb = (4 * hh + ((lane & 15) >> 2)) * VP + (16 * ((lane >> 4) & 1) + 4 * (lane & 3)) * 2;
    const bool xloc = ((int)gridDim.x == 256);
    const int lw = ((int)blockIdx.x >> 3) * NWAVES + F.wave, xq = (int)blockIdx.x & 7;
    for (int item = xloc ? lw : gw; item < (xloc ? 512 : nitems); item += (xloc ? 256 : NGW)) {
        int ut, r, h, b;
        if (xloc) { constexpr int nth = ntile / 2; const int utl = item % nth; int rest = item / nth; r = rest % d; h = rest / d; ut = (xq & 1) * nth + utl; b = xq >> 1; }
        else { ut = item % ntile; int rest = item / ntile; r = rest % d; rest /= d; h = rest & 15; b = rest >> 4; }
        const int u0 = ut * 64;
        const size_t rowqA = (size_t)b * T_ + (size_t)(u0 + ql) * d + r, rowqB = rowqA + (size_t)32 * d;
        bf16x8 qA[4], qB[4];
#pragma unroll
        for (int s = 0; s < 4; ++s) { qA[s] = *(const bf16x8*)(Qb + rowqA * D_ + h * 64 + 16 * s + 8 * hh); qB[s] = *(const bf16x8*)(Qb + rowqB * D_ + h * 64 + 16 * s + 8 * hh); }
        const float slope2 = fast_exp2(-0.5f * (float)(h + 1)) * (float)d * LOG2E;
        float mxA = 0.f, lsA = 0.f, mxB = 0.f, lsB = 0.f;
        f32x16 oA0, oA1, oB0, oB1;
#pragma unroll
        for (int i = 0; i < 16; ++i) { oA0[i] = 0.f; oA1[i] = 0.f; oB0[i] = 0.f; oB1[i] = 0.f; }
#define ATT_LOAD(TI, KF, VV) do { const int ub_ = u0 - 128 + 32 * (TI); const size_t rowk_ = (size_t)b * T_ + (size_t)(ub_ + ql) * d + r; \
            _Pragma("unroll") for (int s = 0; s < 4; ++s) KF[s] = *(const bf16x8*)(Kb + rowk_ * D_ + h * 64 + 16 * s + 8 * hh); \
            _Pragma("unroll") for (int j = 0; j < 4; ++j) { const size_t rowv_ = (size_t)b * T_ + (size_t)(ub_ + 8 * j + (lane >> 3)) * d + r; VV[j] = *(const u32x4*)(Vb + rowv_ * D_ + h * 64 + (lane & 7) * 8); } } while (0)
#define ATT_TILE2(KF, VV, TI) do { const int i_ = (TI); u32x4 pwA[2], pwB[2]; \
            att_scores(KF, qA, i_, ql, hh, slope2, mxA, lsA, oA0, oA1, pwA); att_scores(KF, qB, i_ - 1, ql, hh, slope2, mxB, lsB, oB0, oB1, pwB); \
            _Pragma("unroll") for (int j = 0; j < 4; ++j) *(LAS u32x4*)(Vs + (8 * j + (lane >> 3)) * VP + (lane & 7) * 16) = VV[j]; \
            __builtin_amdgcn_s_setprio(1); \
            _Pragma("unroll") for (int dt = 0; dt < 2; ++dt) _Pragma("unroll") for (int s = 0; s < 2; ++s) { \
                const s16x4 lo = __builtin_bit_cast(s16x4, __builtin_amdgcn_ds_read_tr16_b64_v4i16((LAS v4i16_t*)(Vs + trb + (16 * s) * VP + dt * 64))); \
                const s16x4 hi = __builtin_bit_cast(s16x4, __builtin_amdgcn_ds_read_tr16_b64_v4i16((LAS v4i16_t*)(Vs + trb + (16 * s + 8) * VP + dt * 64))); \
                const bf16x8 vf = __builtin_shufflevector(lo, hi, 0, 1, 2, 3, 4, 5, 6, 7); \
                { if (dt == 0) oA0 = __builtin_amdgcn_mfma_f32_32x32x16_bf16(vf, __builtin_bit_cast(bf16x8, pwA[s]), oA0, 0, 0, 0); else oA1 = __builtin_amdgcn_mfma_f32_32x32x16_bf16(vf, __builtin_bit_cast(bf16x8, pwA[s]), oA1, 0, 0, 0); } \
                { if (dt == 0) oB0 = __builtin_amdgcn_mfma_f32_32x32x16_bf16(vf, __builtin_bit_cast(bf16x8, pwB[s]), oB0, 0, 0, 0); else oB1 = __builtin_amdgcn_mfma_f32_32x32x16_bf16(vf, __builtin_bit_cast(bf16x8, pwB[s]), oB1, 0, 0, 0); } } \
            __builtin_amdgcn_s_setprio(0); } while (0)
#define ATT_TILE2X(KF, VV, TI, DOA, DOB) do { u32x4 pwA[2], pwB[2]; \
            if (DOA) att_scores(KF, qA, (TI), ql, hh, slope2, mxA, lsA, oA0, oA1, pwA); if (DOB) att_scores(KF, qB, (TI) - 1, ql, hh, slope2, mxB, lsB, oB0, oB1, pwB); \
            _Pragma("unroll") for (int j = 0; j < 4; ++j) *(LAS u32x4*)(Vs + (8 * j + (lane >> 3)) * VP + (lane & 7) * 16) = VV[j]; \
            __builtin_amdgcn_s_setprio(1); \
            _Pragma("unroll") for (int dt = 0; dt < 2; ++dt) _Pragma("unroll") for (int s = 0; s < 2; ++s) { \
                const s16x4 lo = __builtin_bit_cast(s16x4, __builtin_amdgcn_ds_read_tr16_b64_v4i16((LAS v4i16_t*)(Vs + trb + (16 * s) * VP + dt * 64))); \
                const s16x4 hi = __builtin_bit_cast(s16x4, __builtin_amdgcn_ds_read_tr16_b64_v4i16((LAS v4i16_t*)(Vs + trb + (16 * s + 8) * VP + dt * 64))); \
                const bf16x8 vf = __builtin_shufflevector(lo, hi, 0, 1, 2, 3, 4, 5, 6, 7); \
                if (DOA) { if (dt == 0) oA0 = __builtin_amdgcn_mfma_f32_32x32x16_bf16(vf, __builtin_bit_cast(bf16x8, pwA[s]), oA0, 0, 0, 0); else oA1 = __builtin_amdgcn_mfma_f32_32x32x16_bf16(vf, __builtin_bit_cast(bf16x8, pwA[s]), oA1, 0, 0, 0); } \
                if (DOB) { if (dt == 0) oB0 = __builtin_amdgcn_mfma_f32_32x32x16_bf16(vf, __builtin_bit_cast(bf16x8, pwB[s]), oB0, 0, 0, 0); else oB1 = __builtin_amdgcn_mfma_f32_32x32x16_bf16(vf, __builtin_bit_cast(bf16x8, pwB[s]), oB1, 0, 0, 0); } } \
            __builtin_amdgcn_s_setprio(0); } while (0)
        const int i0 = (ut >= 2) ? 0 : 4 - 2 * ut;
        bf16x8 k0[4]; u32x4 v0[4];
        if (i0 == 0) {
            ATT_LOAD(0, k0, v0); ATT_TILE2X(k0, v0, 0, true, false); __builtin_amdgcn_sched_barrier(0);
            ATT_LOAD(1, k0, v0); ATT_TILE2X(k0, v0, 1, true, true); __builtin_amdgcn_sched_barrier(0);
            ATT_LOAD(2, k0, v0); ATT_TILE2X(k0, v0, 2, true, true); __builtin_amdgcn_sched_barrier(0);
            ATT_LOAD(3, k0, v0); ATT_TILE2X(k0, v0, 3, true, true); __builtin_amdgcn_sched_barrier(0);
            ATT_LOAD(4, k0, v0); ATT_TILE2X(k0, v0, 4, true, true); __builtin_amdgcn_sched_barrier(0);
            ATT_LOAD(5, k0, v0); ATT_TILE2X(k0, v0, 5, false, true);
        } else {
#pragma unroll 1
            for (int i = i0; i < 6; ++i) {
                ATT_LOAD(i, k0, v0);
                ATT_TILE2(k0, v0, i);
            }
        }
#undef ATT_TILE2X
#undef ATT_LOAD
#undef ATT_TILE2
#define ATT_EPI(O0, O1, MX, LS, ROWQ, UQ) do { \
        const float l = LS + __shfl_xor(LS, 32); \
        float wprev = 0.f, wcur, lse_new; \
        if (G_ == 2) { wcur = fast_rcp(l); lse_new = MX + __log2f(l); } \
        else { const float lp = LSE[ROWQ * 16 + h], M2 = fmaxf(lp, MX); const float wp = fast_exp2(lp - M2), wc = fast_exp2(MX - M2), den = wp + wc * l, rden = fast_rcp(den); \
            wprev = wp * rden; wcur = wc * rden; lse_new = M2 + __log2f(den); } \
        _Pragma("unroll") for (int dt = 0; dt < 2; ++dt) _Pragma("unroll") for (int c = 0; c < 4; ++c) { f32x4 v; \
            if (dt == 0) { v[0] = O0[4 * c] * wcur; v[1] = O0[4 * c + 1] * wcur; v[2] = O0[4 * c + 2] * wcur; v[3] = O0[4 * c + 3] * wcur; } \
            else { v[0] = O1[4 * c] * wcur; v[1] = O1[4 * c + 1] * wcur; v[2] = O1[4 * c + 2] * wcur; v[3] = O1[4 * c + 3] * wcur; } \
            *(LAS f32x4*)(Os + ql * 68 + 32 * dt + 8 * c + 4 * hh) = v; } \
        if (hh == 0) wtab[ql] = wprev; \
        _Pragma("unroll") for (int j = 0; j < 4; ++j) { const int qi = 8 * j + (lane >> 3), ch = lane & 7; \
            const f32x4 a = *(const LAS f32x4*)(Os + qi * 68 + ch * 8), c4 = *(const LAS f32x4*)(Os + qi * 68 + ch * 8 + 4); \
            u32x4* pp = (u32x4*)(OUT + ((size_t)b * T_ + (size_t)((UQ) + qi) * d + r) * D_ + h * 64 + ch * 8); \
            float r8[8] = {a[0], a[1], a[2], a[3], c4[0], c4[1], c4[2], c4[3]}; \
            if (G_ != 2) { const float wp = wtab[qi]; const u32x4 pv = *pp; \
                r8[0] += wp * bflo(pv.x); r8[1] += wp * bfhi(pv.x); r8[2] += wp * bflo(pv.y); r8[3] += wp * bfhi(pv.y); r8[4] += wp * bflo(pv.z); r8[5] += wp * bfhi(pv.z); r8[6] += wp * bflo(pv.w); r8[7] += wp * bfhi(pv.w); } \
            u32x4 w; w.x = cvtpk(r8[0], r8[1]); w.y = cvtpk(r8[2], r8[3]); w.z = cvtpk(r8[4], r8[5]); w.w = cvtpk(r8[6], r8[7]); \
            *pp = w; } \
        if (hh == 0) LSE[ROWQ * 16 + h] = lse_new; } while (0)
        ATT_EPI(oA0, oA1, mxA, lsA, rowqA, u0);
        ATT_EPI(oB0, oB1, mxB, lsB, rowqB, u0 + 32);
#undef ATT_EPI
    }
}

template <int YPITCH> __device__ __forceinline__ void p3_ssd_v4(const Frame& F, bf16_t* YO) {
    constexpr int ypitch = YPITCH;
    constexpr int O_IMG = 0, IMG_SET = 24576, O_ARR = 49152, ARR_SET = 1600, O_ST = 52352, ST_SET = 8192, O_ACS = 68736, O_TOT = 85120, O_YP = 85248, O_YA = 89344, O_XR = 89360, XR_W = 2240, O_HALO = 98320, O_YT = 98816;
#define SSD_BAR() do { asm volatile("s_waitcnt lgkmcnt(0)" ::: "memory"); __builtin_amdgcn_s_barrier(); asm volatile("" ::: "memory"); } while (0)
    LAS unsigned char* L = F.lds;
    bf16_t* BIG = (bf16_t*)(F.a.ws + WS_BIG); const bf16_t* BC = (const bf16_t*)(F.a.ws + WS_AUX); const float* DT = (const float*)(F.a.ws + WS_DT);
    const bf16_t* CBT = (const bf16_t*)F.a.out;
    LAS float* acs_all = (LAS float*)(F.lds + O_ACS); LAS float* tot_all = (LAS float*)(F.lds + O_TOT);
    const int tid = F.tid, lane = F.lane, wave = F.wave, ql = lane & 31, hh = lane >> 5;
    LAS float* YoffP = (LAS float*)(L + O_YP); LAS unsigned* yflag = (LAS unsigned*)(L + O_YA);
    for (int u0_ = blockIdx.x; u0_ < 256; u0_ += gridDim.x) {
        const int u = (gridDim.x == 256) ? (((u0_ & 7) + 8 * (u0_ >> 7)) * 16 + ((u0_ >> 3) & 15)) : u0_;
        const int b = u >> 6, h = (u >> 1) & 31, ph = u & 1, g = h >> 3, ch0 = h * 64 + ph * 32;
        const float A_h = -__expf(F.a.in[I_ALOG][h]), D_h = F.a.in[I_DSKIP][h];
        float cwv[4];
#pragma unroll
        for (int k = 0; k < 4; ++k) cwv[k] = F.a.in[I_CW][k * XBC + ch0 + ql];
        const float cbv = F.a.in[I_CB][ch0 + ql];
        f32x16 st;
#pragma unroll
        for (int i = 0; i < 16; ++i) st[i] = 0.f;
        u32x4 fr[8];
        const int ftile = (wave >= 4) ? (wave - 4) : (wave == 0) ? 3 : (wave == 1) ? 0 : (wave == 2) ? 2 : 1;
#define SSD_FLOAD(cc) do { const bf16_t* fp_ = BC + ((size_t)(b * 32 + (cc)) * 4 + g) * 32768 + ((wave >= 4) ? 0 : 16384) + (size_t)ftile * 8 * 512 + lane * 8; \
            _Pragma("unroll") for (int k = 0; k < 8; ++k) fr[k] = *(const u32x4*)(fp_ + k * 512); } while (0)
        u32x4 sx[6]; float dta = 0.f, dtb = 0.f;
        const int wq = wave - 4;
#define SSD_XLOAD(cc) do { const size_t r0_ = (size_t)b * T_ + (size_t)(cc) * 128; \
            _Pragma("unroll") for (int i = 0; i < 3; ++i) { const int j = 16 * i + (lane >> 2); const long grow = (long)r0_ + 32 * wq - 3 + j; \
                const bool inb = (j < 35) && !(wq == 0 && j < 3); sx[i] = inb ? *(const u32x4*)(BIG + grow * XBC + ch0 + (lane & 3) * 8) : (u32x4){0u, 0u, 0u, 0u}; } \
            dta = DT[(r0_ + 2 * lane) * 32 + h]; dtb = DT[(r0_ + 2 * lane + 1) * 32 + h]; } while (0)
        const int lt0 = (wave < 2) ? 3 : (wave == 2) ? 2 : 1, s_lo0 = (wave == 1) ? 2 : 0, s_hi0 = (wave == 0) ? 1 : (wave == 1) ? 3 : (wave == 2) ? 2 : 1;
#define SSD_SLOAD(cc) do { const bf16_t* jb_ = CBT + ((size_t)(b * 32 + (cc)) * 4 + g) * 10 * CBT_TILE_ELEMS + lane * 16; \
            _Pragma("unroll") for (int k = 0; k < 3; ++k) if (s_lo0 + k <= s_hi0) { const bf16_t* sp = jb_ + (size_t)(lt0 * (lt0 + 1) / 2 + s_lo0 + k) * CBT_TILE_ELEMS; sx[2 * k] = *(const u32x4*)sp; sx[2 * k + 1] = *(const u32x4*)(sp + 8); } \
            if (wave == 1) { sx[4] = *(const u32x4*)jb_; sx[5] = *(const u32x4*)(jb_ + 8); } } while (0)
#define SSD_PREP(cc) do { const int sn_ = (cc) & 1; LAS unsigned char* xrw = L + O_XR + wq * XR_W; \
            LAS float* dts_ = (LAS float*)(L + O_ARR + sn_ * ARR_SET); LAS float* ea_ = dts_ + 128; LAS float* wd_ = dts_ + 256; \
              \
            _Pragma("unroll") for (int i = 0; i < 3; ++i) { const int j = 16 * i + (lane >> 2); \
                u32x4 v = sx[i]; if (wq == 0 && j < 3) v = *(const LAS u32x4*)(L + O_HALO + sn_ * 192 + j * 64 + (lane & 3) * 16); \
                if (j < 35) *(LAS u32x4*)(xrw + j * 64 + (lane & 3) * 16) = v; \
                if (wq == 3 && j >= 32 && j < 35) *(LAS u32x4*)(L + O_HALO + (sn_ ^ 1) * 192 + (j - 32) * 64 + (lane & 3) * 16) = v; } \
              \
            { const float e0 = acs_all[(cc) * 128 + 2 * lane], e1 = acs_all[(cc) * 128 + 2 * lane + 1], tot = tot_all[(cc)]; \
              dts_[2 * lane] = dta; dts_[2 * lane + 1] = dtb; ea_[2 * lane] = __expf(e0); ea_[2 * lane + 1] = __expf(e1); \
              wd_[2 * lane] = __expf(tot - e0); wd_[2 * lane + 1] = __expf(tot - e1); if (lane == 0) dts_[384] = __expf(tot); } \
              \
            { _Pragma("unroll 1") for (int k2 = 0; k2 < 2; ++k2) { float xr_[11]; float xcv[8], xsv[8], xwv[8]; \
                  _Pragma("unroll") for (int i = 0; i < 11; ++i) xr_[i] = __uint_as_float((unsigned)*(const LAS bf16_t*)(xrw + (16 * hh + 8 * k2 + i) * 64 + ql * 2) << 16); \
                  _Pragma("unroll") for (int j = 0; j < 8; ++j) { const int jj = 8 * k2 + j; float v = cbv; \
                      _Pragma("unroll") for (int k = 0; k < 4; ++k) v += cwv[k] * xr_[j + k]; \
                      const int l_ = 32 * wq + 16 * hh + jj; xcv[j] = siluf_(v); xsv[j] = xcv[j] * dts_[l_]; xwv[j] = xsv[j] * wd_[l_]; } \
                  u32x4 w0, w1, w2; \
                  w0.x = cvtpk(xcv[0], xcv[1]); w0.y = cvtpk(xcv[2], xcv[3]); w0.z = cvtpk(xcv[4], xcv[5]); w0.w = cvtpk(xcv[6], xcv[7]); \
                  w1.x = cvtpk(xsv[0], xsv[1]); w1.y = cvtpk(xsv[2], xsv[3]); w1.z = cvtpk(xsv[4], xsv[5]); w1.w = cvtpk(xsv[6], xsv[7]); \
                  w2.x = cvtpk(xwv[0], xwv[1]); w2.y = cvtpk(xwv[2], xwv[3]); w2.z = cvtpk(xwv[4], xwv[5]); w2.w = cvtpk(xwv[6], xwv[7]); \
                  const unsigned o = off_b(ql, 4 * wq + 2 * hh + k2); LAS unsigned char* img = L + O_IMG + sn_ * IMG_SET; \
                  *(LAS u32x4*)(img + o) = w1; *(LAS u32x4*)(img + 8192 + o) = w2; *(LAS u32x4*)(img + 16384 + o) = w0; } } } while (0)
        { float da[4], db[4];
#pragma unroll
          for (int k = 0; k < 4; ++k) { const size_t r0_ = (size_t)b * T_ + (size_t)(wave + 8 * k) * 128; da[k] = DT[(r0_ + 2 * lane) * 32 + h]; db[k] = DT[(r0_ + 2 * lane + 1) * 32 + h]; }
#pragma unroll
          for (int k = 0; k < 4; ++k) { const int cc = wave + 8 * k; const float a0 = da[k] * A_h, a1 = db[k] * A_h; float v = a0 + a1;
#pragma unroll
              for (int off = 1; off < 64; off <<= 1) { const float t = __shfl_up(v, off); if (lane >= off) v += t; }
              acs_all[cc * 128 + 2 * lane] = v - a1; acs_all[cc * 128 + 2 * lane + 1] = v; if (lane == 63) tot_all[cc] = v; } }
        if (tid < 48) *(LAS unsigned*)(L + O_HALO + tid * 4) = 0u;
        if (tid == 0) *yflag = 0u;
        SSD_BAR();
        if (wave >= 4) {
#pragma unroll
            for (int s2 = 0; s2 < 2; ++s2) *(LAS u32x4*)(L + O_ST + ((wave - 4) * 2 + s2) * 1024 + lane * 16) = (u32x4){0u, 0u, 0u, 0u};
            SSD_XLOAD(0); SSD_PREP(0); SSD_XLOAD(1);
        } else SSD_SLOAD(0);
        SSD_FLOAD(0);
        SSD_BAR();
        for (int c = 0; c < T_ / 128; ++c) {
            int lane_o = F.lane; asm volatile("" : "+v"(lane_o)); const int lane = lane_o, ql = lane & 31, hh = lane >> 5;
            const int sc = c & 1;
            const size_t row0 = (size_t)b * T_ + (size_t)c * 128;
            LAS unsigned char* img = L + O_IMG + sc * IMG_SET;
            LAS float* dts = (LAS float*)(L + O_ARR + sc * ARR_SET); LAS float* ea = dts + 128; LAS float* acs = acs_all + c * 128;
            if (wave < 4) {
#pragma unroll 1
                for (int pass = 0; pass < 2; ++pass) {
                    if (pass == 1 && wave != 1) break;
                    const int lt = (pass == 1) ? 0 : (wave < 2) ? 3 : (wave == 2) ? 2 : 1;
                    const int s_lo = (pass == 0 && wave == 1) ? 2 : 0;
                    const int s_hi = (pass == 1) ? 0 : (wave == 0) ? 1 : (wave == 1) ? 3 : (wave == 2) ? 2 : 1;
                    f32x16 y;
#pragma unroll
                    for (int i = 0; i < 16; ++i) y[i] = 0.f;
                    if (!(wave == 1 && pass == 0)) {
                        __builtin_amdgcn_s_setprio(1);
#pragma unroll
                        for (int kg = 0; kg < 8; ++kg) {
                            const bf16x8 bfv = *(const LAS bf16x8*)(L + O_ST + sc * ST_SET + kg * 1024 + lane * 16);
                            y = __builtin_amdgcn_mfma_f32_32x32x16_bf16(__builtin_bit_cast(bf16x8, fr[kg]), bfv, y, 0, 0, 0);
                            if (kg == 3) __builtin_amdgcn_sched_barrier(0);
                        }
                        __builtin_amdgcn_s_setprio(0);
#pragma unroll
                        for (int c4 = 0; c4 < 4; ++c4) { const f32x4 e = *(const LAS f32x4*)(ea + 32 * lt + 8 * c4 + 4 * hh);
                            const u32x2 xv = *(const LAS u32x2*)(img + 16384 + off_b(ql, 4 * lt + c4) + 8 * hh);
                            y[4 * c4] = y[4 * c4] * e[0] + D_h * bflo(xv.x); y[4 * c4 + 1] = y[4 * c4 + 1] * e[1] + D_h * bfhi(xv.x);
                            y[4 * c4 + 2] = y[4 * c4 + 2] * e[2] + D_h * bflo(xv.y); y[4 * c4 + 3] = y[4 * c4 + 3] * e[3] + D_h * bfhi(xv.y); }
                    }
                    const float acs_l = acs[32 * lt + ql];
#pragma unroll
                    for (int k = 0; k < 3; ++k) {
                        const int stl = s_lo + k;
                        if (stl > s_hi) break;
                        const u32x4 w0 = (pass == 1) ? sx[4] : sx[2 * k], w1 = (pass == 1) ? sx[5] : sx[2 * k + 1];
                        f32x16 S;
                        S[0] = bflo(w0.x); S[1] = bfhi(w0.x); S[2] = bflo(w0.y); S[3] = bfhi(w0.y); S[4] = bflo(w0.z); S[5] = bfhi(w0.z); S[6] = bflo(w0.w); S[7] = bfhi(w0.w);
                        S[8] = bflo(w1.x); S[9] = bfhi(w1.x); S[10] = bflo(w1.y); S[11] = bfhi(w1.y); S[12] = bflo(w1.z); S[13] = bfhi(w1.z); S[14] = bflo(w1.w); S[15] = bfhi(w1.w);
#pragma unroll
                        for (int c4 = 0; c4 < 4; ++c4) { const f32x4 as = *(const LAS f32x4*)(acs + 32 * stl + 8 * c4 + 4 * hh);
#pragma unroll
                            for (int j = 0; j < 4; ++j) { const int sidx = 8 * c4 + 4 * hh + j; const bool ok = (stl < lt) || (sidx <= ql);
                                S[4 * c4 + j] = ok ? S[4 * c4 + j] * __expf(acs_l - as[j]) : 0.f; } }
#pragma unroll
                        for (int s2 = 0; s2 < 2; ++s2) {
                            u32x4 wf; wf.x = cvtpk(S[8 * s2], S[8 * s2 + 1]); wf.y = cvtpk(S[8 * s2 + 2], S[8 * s2 + 3]); wf.z = cvtpk(S[8 * s2 + 4], S[8 * s2 + 5]); wf.w = cvtpk(S[8 * s2 + 6], S[8 * s2 + 7]);
                            const int kg = 2 * stl + s2;
                            const u32x2 xlo = *(const LAS u32x2*)(img + off_b(ql, 2 * kg) + 8 * hh), xhi = *(const LAS u32x2*)(img + off_b(ql, 2 * kg + 1) + 8 * hh);
                            const u32x4 xb = {xlo.x, xlo.y, xhi.x, xhi.y};
                            y = __builtin_amdgcn_mfma_f32_32x32x16_bf16(__builtin_bit_cast(bf16x8, wf), __builtin_bit_cast(bf16x8, xb), y, 0, 0, 0);
                        }
                    }
                    if (wave == 1 && pass == 0) {
#pragma unroll
                        for (int r = 0; r < 16; ++r) YoffP[((r & 3) + 8 * (r >> 2) + 4 * hh) * 32 + ql] = y[r];
                        if (lane == 0) __hip_atomic_store(yflag, (unsigned)(c + 1), __ATOMIC_RELAXED, __HIP_MEMORY_SCOPE_WORKGROUP);
                    } else {
                        if (wave == 0) {
                            unsigned spins = 0;
                            while (__hip_atomic_load(yflag, __ATOMIC_RELAXED, __HIP_MEMORY_SCOPE_WORKGROUP) != (unsigned)(c + 1) && ++spins < (1u << 22)) __builtin_amdgcn_s_sleep(1);
                            asm volatile("" ::: "memory");
#pragma unroll
                            for (int r = 0; r < 16; ++r) y[r] += YoffP[((r & 3) + 8 * (r >> 2) + 4 * hh) * 32 + ql];
                        }
                        {
                            LAS unsigned char* yt = L + O_YT + wave * 2048;
#pragma unroll
                            for (int r = 0; r < 16; ++r) *(LAS bf16_t*)(yt + ((r & 3) + 8 * (r >> 2) + 4 * hh) * 64 + ql * 2) = (bf16_t)(cvtpk(y[r], 0.f) & 0xffffu);
#pragma unroll
                            for (int k2 = 0; k2 < 2; ++k2) { const int kk = lane + 64 * k2, li = kk >> 2, c4 = kk & 3;
                                const u32x4 w = *(const LAS u32x4*)(yt + li * 64 + c4 * 16);
                                *(u32x4*)(YO + (row0 + 32 * lt + li) * ypitch + ch0 + c4 * 8) = w; }
                        }
                    }
                }
                SSD_SLOAD(c + 1 < T_ / 128 ? c + 1 : c); SSD_FLOAD(c + 1 < T_ / 128 ? c + 1 : c);
            } else {
                const int nt = wave - 4, lt = nt;
                {
                const float cd = dts[384];
#pragma unroll
                for (int i = 0; i < 16; ++i) st[i] *= cd;
                __builtin_amdgcn_s_setprio(1);
#pragma unroll
                for (int ks = 0; ks < 8; ++ks) {
                    const bf16x8 bfv = *(const LAS bf16x8*)(img + 8192 + off_b(ql, 2 * ks + hh));
                    st = __builtin_amdgcn_mfma_f32_32x32x16_bf16(__builtin_bit_cast(bf16x8, fr[ks]), bfv, st, 0, 0, 0);
                    if (ks == 3) __builtin_amdgcn_sched_barrier(0);
                }
                __builtin_amdgcn_s_setprio(0);
                }
#pragma unroll
                for (int s2 = 0; s2 < 2; ++s2) { u32x4 w; w.x = cvtpk(st[8 * s2], st[8 * s2 + 1]); w.y = cvtpk(st[8 * s2 + 2], st[8 * s2 + 3]); w.z = cvtpk(st[8 * s2 + 4], st[8 * s2 + 5]); w.w = cvtpk(st[8 * s2 + 6], st[8 * s2 + 7]);
                    *(LAS u32x4*)(L + O_ST + (sc ^ 1) * ST_SET + ((wave - 4) * 2 + s2) * 1024 + lane * 16) = w; }
                SSD_FLOAD(c + 1 < T_ / 128 ? c + 1 : c);
                if (c + 1 < T_ / 128) { SSD_PREP(c + 1); SSD_XLOAD(c + 2 < T_ / 128 ? c + 2 : c + 1); }
            }
            SSD_BAR();
        }
#undef SSD_FLOAD
#undef SSD_XLOAD
#undef SSD_SLOAD
#undef SSD_PREP
        SSD_BAR();
    }
}

enum { E_STORE = 0, E_Z, E_RES, E_GATE, E_GU, E_QKV, E_FINAL, E_RESSEG };
struct GOp { const bf16_t* A; const bf16_t* Bt; int lda, N, K, epi; bf16_t* ob; bf16_t* ob2; bf16_t* ob3; int ldc; const float* SS; float* SSo; const bf16_t* xin; bf16_t* xo; const bf16_t* ple; };

__device__ __forceinline__ void run_gemm(const Frame& F, const GOp& op) {
    pg8::Gemm g{op.A, op.Bt, M_, op.N, op.K, op.lda};
    pg8::StaticOrder S; S.init(M_, op.N, (int)gridDim.x, (int)blockIdx.x);
    LAS float* tab = (LAS float*)(F.lds + RING_BYTES + 1024);
    switch (op.epi) {
    case E_STORE: { pg8::EpiStore E{op.ob, op.ldc, op.SS, tab}; pg8::gemm_phase(F.lds, F.tid, g, S, E); } break;
    case E_Z: { pg8::EpiZ E{op.ob, op.SS, (float*)(F.a.ws + WS_GN), tab}; pg8::gemm_phase(F.lds, F.tid, g, S, E); } break;
    case E_RES: { pg8::EpiRes<false, false> E{nullptr, op.xin, op.xo, op.SSo, nullptr, nullptr, nullptr}; pg8::gemm_phase(F.lds, F.tid, g, S, E); } break;
    case E_RESSEG: { pg8::EpiRes<false, false, true> E{nullptr, op.xin, op.xo, op.SSo, nullptr, (const float*)(F.a.ws + WS_GN), (LAS float*)(F.lds + RING_BYTES + 2048)}; pg8::gemm_phase(F.lds, F.tid, g, S, E); } break;
    case E_GATE: { pg8::EpiRes<true, false> E{nullptr, op.xin, op.xo, op.SSo, op.ple, nullptr, nullptr}; pg8::gemm_phase(F.lds, F.tid, g, S, E); } break;
    case E_FINAL: { pg8::EpiRes<true, true> E{F.a.out, op.xin, nullptr, nullptr, op.ple, nullptr, nullptr}; pg8::gemm_phase(F.lds, F.tid, g, S, E); } break;
    case E_GU: { pg8::EpiGU E{op.ob, op.SS, tab}; pg8::gemm_phase(F.lds, F.tid, g, S, E); } break;
    case E_QKV: { pg8::EpiQKV E{op.ob, (long)(op.ob2 - op.ob), (long)(op.ob3 - op.ob), op.SS, F.a.in[I_QN], F.a.in[I_KN], tab}; pg8::gemm_phase(F.lds, F.tid, g, S, E); } break;
    default: break;
    }
}

constexpr int NPHASE = 20;
__device__ __forceinline__ bool phase_gemm(const Frame& F, int ph, int i, GOp& g0) {
    unsigned char* ws = F.a.ws;
    bf16_t* XB = (bf16_t*)(ws + WS_XB); bf16_t* BIG = (bf16_t*)(ws + WS_BIG); bf16_t* AUX = (bf16_t*)(ws + WS_AUX); bf16_t* PB = (bf16_t*)(ws + WS_PB);
    float* SS = (float*)(ws + WS_SS);
    bf16_t* X2 = (bf16_t*)F.a.out;
    GOp z{}; g0 = z;
    auto W = [&](size_t off) { return (const bf16_t*)(ws + off); };
    if (i == 1) {
        if (ph != 8 && ph != 18) return false;
        g0.A = (ph == 8) ? PB : PB + (size_t)M_ * PLED; g0.lda = 256; g0.Bt = W(ph == 8 ? W_PP0 : W_PP1); g0.N = 1024; g0.K = 256; g0.epi = E_STORE; g0.ob = AUX; g0.ldc = 1024; g0.SS = nullptr; return true;
    }
    switch (ph) {
    case 1: g0.A = XB; g0.lda = 1024; g0.Bt = W(W_XBC); g0.N = 3072; g0.K = 1024; g0.epi = E_STORE; g0.ob = BIG; g0.ldc = XBC; g0.SS = SS; return true;
    case 4: g0.A = XB; g0.lda = 1024; g0.Bt = W(W_Z); g0.N = 2048; g0.K = 1024; g0.epi = E_Z; g0.ob = BIG; g0.SS = SS; return true;
    case 6: g0.A = BIG; g0.lda = XBC; g0.Bt = W(W_OUT); g0.N = 1024; g0.K = 2048; g0.epi = E_RESSEG; g0.xin = XB; g0.xo = XB; g0.SSo = SS; return true;
    case 7: g0.A = XB; g0.lda = 1024; g0.Bt = W(W_GU0); g0.N = 5632; g0.K = 1024; g0.epi = E_GU; g0.ob = BIG; g0.SS = SS; return true;
    case 8: g0.A = BIG; g0.lda = FF; g0.Bt = W(W_D0); g0.N = 1024; g0.K = FF; g0.epi = E_RES; g0.xin = XB; g0.xo = XB; g0.SSo = nullptr; return true;
    case 9: g0.A = XB; g0.lda = 1024; g0.Bt = W(W_PG0); g0.N = 1024; g0.K = 1024; g0.epi = E_GATE; g0.xin = XB; g0.xo = X2; g0.SSo = SS; g0.ple = AUX; return true;
    case 10: case 11: case 13: { const int g = (ph <= 11) ? 12 - ph : 0;   const QKVSet qs = qkv_set(ws, F.a.out, ph == 11 ? 1 : 0);
            g0.A = X2; g0.lda = 1024; g0.Bt = W(W_QKV) + (size_t)g * QG * 1024; g0.N = QG; g0.K = 1024; g0.epi = E_QKV; g0.ob = qs.q; g0.ob2 = qs.k; g0.ob3 = qs.v; g0.SS = SS; return true; }
    case 16: g0.A = AUX; g0.lda = 1024; g0.Bt = W(W_O); g0.N = 1024; g0.K = 1024; g0.epi = E_RES; g0.xin = X2; g0.xo = XB; g0.SSo = SS; return true;
    case 17: g0.A = XB; g0.lda = 1024; g0.Bt = W(W_GU1); g0.N = 5632; g0.K = 1024; g0.epi = E_GU; g0.ob = BIG; g0.SS = SS; return true;
    case 18: g0.A = BIG; g0.lda = FF; g0.Bt = W(W_D1); g0.N = 1024; g0.K = FF; g0.epi = E_RES; g0.xin = XB; g0.xo = XB; g0.SSo = nullptr; return true;
    case 19: g0.A = XB; g0.lda = 1024; g0.Bt = W(W_PG1); g0.N = 1024; g0.K = 1024; g0.epi = E_FINAL; g0.xin = XB; g0.ple = AUX; return true;
    default: return false;
    }
}

__global__ void __launch_bounds__(NTHREADS, 2) mk_fwd(Args args) {
    extern __shared__ __attribute__((aligned(16))) unsigned char lds_raw[];
    Frame F(args);
    F.lds = (LAS unsigned char*)lds_raw;
    F.tid = threadIdx.x; F.lane = F.tid & 63; F.wave = __builtin_amdgcn_readfirstlane(F.tid >> 6);
    for (int u = F.tid; u < (LDS_BYTES - LDSCTL_OFF) / 4; u += NTHREADS) ((LAS unsigned*)(F.lds + LDSCTL_OFF))[u] = 0u;
    __syncthreads();
    const int lo = args.ph_lo, hi = args.ph_hi;
    XcdBarrier bar; bar.bar = (unsigned*)(F.a.ws + WS_CTL) + 4096; bar.x = 0; bar.st = nullptr;
    unsigned bar_epoch = 0u;
    if (hi - lo > 1) bar = xcd_barrier_post((unsigned*)(F.a.ws + WS_CTL) + 4096, (volatile LAS unsigned*)(F.lds + MISC_OFF) + 8);

    for (int ph0 = lo; ph0 < hi + DUP_N; ++ph0) {
        int ph = ph0; if (DUP_N > 0) { if (DUP_PHASE >= NPHASE) { if (ph0 >= NPHASE) ph = 99; } else if (ph0 > DUP_PHASE + DUP_N) ph = ph0 - DUP_N; else if (ph0 > DUP_PHASE) ph = DUP_PHASE; }
        if (ph == 5 || ph == 12 || ph == 14) continue;
        { int t_ = threadIdx.x; asm volatile("" : "+v"(t_)); F.tid = t_; F.lane = t_ & 63; F.wave = __builtin_amdgcn_readfirstlane(t_ >> 6); }
        if (ph >= 4 && ph <= 16) { jit_weights(F, ph, true); __syncthreads(); }
        switch (ph) {
        case 0: p0_prologue(F); break;
        case 2: p2_conv_dt(F); break;
        case 3: p3_ssd_v4<XBC>(F, (bf16_t*)(F.a.ws + WS_BIG)); break;
        case 11: att_mfma2<2>(F, qkv_set(F.a.ws, F.a.out, 0)); break;
        case 13: att_mfma2<1>(F, qkv_set(F.a.ws, F.a.out, 1)); break;
        case 15: att_mfma2<0>(F, qkv_set(F.a.ws, F.a.out, 0)); break;
        default: break;
        }
        __syncthreads();
        for (int i = 0; i < 2; ++i) { GOp op; if (!phase_gemm(F, ph, i, op)) break;
            { int t_ = threadIdx.x; asm volatile("" : "+v"(t_)); F.tid = t_; F.lane = t_ & 63; F.wave = __builtin_amdgcn_readfirstlane(t_ >> 6); }
            run_gemm(F, op); }
        if (ph == 7 || ph == 17) {
            const int fb = ((int)gridDim.x == 256) ? 128 : 0; const size_t po = (ph == 7) ? 0 : (size_t)M_ * PLED;
            cvt_flat(F, F.a.in[I_P] + po, (bf16_t*)(F.a.ws + WS_PB) + po, (size_t)M_ * PLED / 8, fb);
        }
        if (ph >= 3 && ph <= 18) {
            __syncthreads();
            { int t_ = threadIdx.x; asm volatile("" : "+v"(t_)); F.tid = t_; F.lane = t_ & 63; F.wave = __builtin_amdgcn_readfirstlane(t_ >> 6); }
            jit_weights(F, ph, false);
        }
        if (ph0 + 1 < hi + DUP_N) xcd_barrier(bar, bar_epoch);
    }
}

extern "C" void kernel_launch(void* const* d_in, const int* in_sizes, int n_in, void* d_out, int out_size, void* d_ws, size_t ws_size, hipStream_t stream) {
    static int grid = 0;
    if (grid == 0) {
        if (n_in != 21 || out_size != M_ * D_ || ws_size < WS_END) { fprintf(stderr, "kernel_launch: unexpected problem (n_in %d, out %d, ws %zu)\n", n_in, out_size, ws_size); grid = -1; return; }
        int dev = 0, cus = 0, per_cu = 0;
        hipGetDevice(&dev); hipDeviceGetAttribute(&cus, hipDeviceAttributeMultiprocessorCount, dev);
        hipFuncSetAttribute((const void*)mk_fwd, hipFuncAttributeMaxDynamicSharedMemorySize, LDS_BYTES);
        hipOccupancyMaxActiveBlocksPerMultiprocessor(&per_cu, (const void*)mk_fwd, NTHREADS, LDS_BYTES);
        if (per_cu < 1) { fprintf(stderr, "kernel_launch: occupancy query says %d blocks/CU\n", per_cu); per_cu = 1; }
        (void)hipGetLastError();
        grid = cus;
        if (grid > cus * per_cu) grid = cus * per_cu;
    }
    if (grid < 0) return;
    hipMemsetAsync((char*)d_ws + WS_CTL, 0, CTL_ZERO_BYTES, stream);
    Args a{};
    for (int i = 0; i < 21; ++i) a.in[i] = (const float*)d_in[i];
    a.out = (float*)d_out; a.ws = (unsigned char*)d_ws;
    a.ph_lo = 0; a.ph_hi = NPHASE;
    void* kargs[] = {&a};
    hipError_t e = hipLaunchCooperativeKernel((const void*)mk_fwd, dim3(grid), dim3(NTHREADS), kargs, LDS_BYTES, stream);
    if (e != hipSuccess) fprintf(stderr, "cooperative launch failed: %s (grid %d)\n", hipGetErrorString(e), grid);
}
```
